# Optimizing an MI355X kernel written in HIP

```python
import math
import jax
import jax.numpy as jnp
from jax import lax
import numpy as np

D_MODEL = 1024
BATCH = 4
SEQ = 8192
DEPTH = 4

GRID_W = 64
CTX_LEN = 256
HEAD_DIM = 64
N_SLOTS = D_MODEL // HEAD_DIM
CONV_CH = D_MODEL // 2
CONV_W = 3
NA_HEADS = N_SLOTS // 2
NA_ROWS = 8
NA_COLS = 16
SWA_HEADS = N_SLOTS // 2
SWA_KV_HEADS = max(1, SWA_HEADS // 4)
SWA_WINDOW = 128
BLOCK = 128
DIFF_HEADS = N_SLOTS // 4
D_FF = 256 * math.ceil(8 * D_MODEL / 3 / 256)
N_EXPERTS = 8
TOP_K = 2
D_FF_EXPERT = D_FF // 2
ROPE_THETA = 10000.0
EPS = 1e-6
NEG = -1e30
N_EVEN = (DEPTH + 1) // 2
N_ODD = DEPTH // 2
NA_W = NA_HEADS * HEAD_DIM
EV_Q = 3 * CONV_CH + NA_W
EV_KV = 2 * NA_W
EV_OUT = CONV_CH + NA_W
C_Q = SWA_HEADS * HEAD_DIM
C_KV = SWA_KV_HEADS * HEAD_DIM
D_QK = DIFF_HEADS * 2 * HEAD_DIM
D_V = DIFF_HEADS * 2 * HEAD_DIM
OD_Q = C_Q + D_QK
OD_KV = 2 * C_KV + D_QK + D_V
OD_OUT = C_Q + D_V

kernel_name = 'hybrid_dit_conv_na_swa_diff_moe'


def rms_norm(x, g):
    xf = x.astype(jnp.float32)
    y = xf * lax.rsqrt(jnp.mean(xf * xf, -1, keepdims=True) + EPS)
    return (y * g.astype(jnp.float32)).astype(x.dtype)


def split_heads(t, h):
    b, n, _ = t.shape
    return t.reshape(b, n, h, -1).transpose(0, 2, 1, 3)


def merge_heads(t):
    b, h, n, d = t.shape
    return t.transpose(0, 2, 1, 3).reshape(b, n, h * d)


def rope_tables(n):
    t = jnp.arange(n)
    pos = jnp.stack([t // GRID_W, t % GRID_W], -1).astype(jnp.float32)
    nq = HEAD_DIM // 4
    inv = ROPE_THETA ** (-jnp.arange(nq, dtype=jnp.float32) / nq)
    ang = pos[:, :, None] * inv
    return jnp.cos(ang), jnp.sin(ang)


def apply_rope(x, cos, sin):
    shp = x.shape
    xr = x.reshape(shp[:-1] + (2, 2, HEAD_DIM // 4))
    a, b = xr[..., 0, :], xr[..., 1, :]
    cos = cos.astype(x.dtype)
    sin = sin.astype(x.dtype)
    return jnp.stack([a * cos - b * sin, b * cos + a * sin], -2).reshape(shp)


def joint_softmax(parts, extra=None):
    m = parts[0].max(-1, keepdims=True)
    for p in parts[1:]:
        m = jnp.maximum(m, p.max(-1, keepdims=True))
    if extra is not None:
        m = jnp.maximum(m, extra)
    es = [jnp.exp(p - m) for p in parts]
    den = es[0].sum(-1, keepdims=True)
    for e in es[1:]:
        den = den + e.sum(-1, keepdims=True)
    if extra is not None:
        den = den + jnp.exp(extra - m)
    return [e / den for e in es]


def dense_attention(q, k, v, sink=None):
    b, hq, lq, d = q.shape
    hkv = k.shape[1]
    g = hq // hkv
    qg = q.reshape(b, hkv, g, lq, d)
    s = jnp.einsum('bkgqd,bkld->bkgql', qg, k, preferred_element_type=jnp.float32) * d ** -0.5
    extra = None if sink is None else sink.astype(jnp.float32).reshape(1, hkv, g, 1, 1)
    (p,) = joint_softmax([s], extra)
    o = jnp.einsum('bkgql,bkld->bkgqd', p.astype(v.dtype), v)
    return o.reshape(b, hq, lq, d)


def dwconv3(u, w):
    return lax.conv_general_dilated(u, w[:, None, :].astype(u.dtype), window_strides=(1,),
                                    padding=[(1, 1)], dimension_numbers=('NWC', 'WIO', 'NWC'),
                                    feature_group_count=u.shape[-1])


def neighbourhood_attention(q, k, v, k_ctx, v_ctx, rpb):
    b, h, n, d = q.shape
    rows = n // GRID_W
    kh = min(NA_ROWS, rows)
    r = jnp.arange(rows)
    col = jnp.arange(GRID_W)
    r0 = jnp.clip(r - kh // 2, 0, rows - kh)
    row_idx = r0[:, None] + jnp.arange(kh)[None, :]
    c0 = jnp.clip(col - NA_COLS // 2, 0, GRID_W - NA_COLS)
    qg = q.reshape(b, h, rows, GRID_W, d)
    kg = k.reshape(b, h, rows, GRID_W, d)[:, :, row_idx]
    vg = v.reshape(b, h, rows, GRID_W, d)[:, :, row_idx]
    dr = row_idx - r[:, None] + NA_ROWS - 1
    dc = jnp.clip(col[None, :] - col[:, None] + NA_COLS - 1, 0, 2 * NA_COLS - 2)
    col_ok = (col[None, :] >= c0[:, None]) & (col[None, :] < c0[:, None] + NA_COLS)
    bias = rpb.astype(jnp.float32)[:, dr[:, None, :, None], dc[None, :, None, :]]
    bias = jnp.where(col_ok[None, None, :, None, :], bias, NEG)
    scale = d ** -0.5
    s_loc = jnp.einsum('bhrqd,bhrjkd->bhrqjk', qg, kg, preferred_element_type=jnp.float32) * scale + bias
    s_ctx = jnp.einsum('bhrqd,bhld->bhrql', qg, k_ctx, preferred_element_type=jnp.float32) * scale
    p_loc, p_ctx = joint_softmax([s_loc.reshape(b, h, rows, GRID_W, kh * GRID_W), s_ctx])
    p_loc = p_loc.reshape(b, h, rows, GRID_W, kh, GRID_W).astype(v.dtype)
    o = (jnp.einsum('bhrqjk,bhrjkd->bhrqd', p_loc, vg)
         + jnp.einsum('bhrql,bhld->bhrqd', p_ctx.astype(v.dtype), v_ctx))
    return o.reshape(b, h, n, d)


def window_gqa(q, k, v, k_ctx, v_ctx, sink):
    b, hq, n, d = q.shape
    hkv = k.shape[1]
    g = hq // hkv
    nb = n // BLOCK
    qb = q.reshape(b, hkv, g, nb, BLOCK, d)
    pad = ((0, 0), (0, 0), (BLOCK, BLOCK), (0, 0))
    band = (jnp.arange(nb) * BLOCK)[:, None] + jnp.arange(3 * BLOCK)[None, :]
    kb = jnp.pad(k, pad)[:, :, band]
    vb = jnp.pad(v, pad)[:, :, band]
    qpos = (jnp.arange(nb) * BLOCK)[:, None, None] + jnp.arange(BLOCK)[None, :, None]
    kpos = band[:, None, :] - BLOCK
    ok = (jnp.abs(kpos - qpos) <= SWA_WINDOW) & (kpos >= 0) & (kpos < n)
    scale = d ** -0.5
    s_loc = jnp.where(ok, jnp.einsum('bkgnqd,bknmd->bkgnqm', qb, kb, preferred_element_type=jnp.float32) * scale, NEG)
    s_ctx = jnp.einsum('bkgnqd,bkld->bkgnql', qb, k_ctx, preferred_element_type=jnp.float32) * scale
    extra = sink.astype(jnp.float32).reshape(1, hkv, g, 1, 1, 1)
    p_loc, p_ctx = joint_softmax([s_loc, s_ctx], extra)
    o = (jnp.einsum('bkgnqm,bknmd->bkgnqd', p_loc.astype(v.dtype), vb)
         + jnp.einsum('bkgnql,bkld->bkgnqd', p_ctx.astype(v.dtype), v_ctx))
    return o.reshape(b, hq, n, d)


def diff_attend(q, kvs, lam):
    scale = q.shape[-1] ** -0.5
    ss = [jnp.einsum('bhiqd,bhikd->bhiqk', q, k, preferred_element_type=jnp.float32) * scale for k, _ in kvs]
    ps = joint_softmax(ss)
    out = None
    for p, (_, v) in zip(ps, kvs):
        a = (p[:, :, 0] - lam * p[:, :, 1]).astype(v.dtype)
        o = jnp.einsum('bhqk,bhkd->bhqd', a, v)
        out = o if out is None else out + o
    return out


def diff_attention_latent(q, k, v, k_ctx, v_ctx, lam):
    b, h, _, n, d = q.shape
    nb = n // BLOCK
    qb = jnp.moveaxis(q.reshape(b, h, 2, nb, BLOCK, d), 3, 0)
    o = lax.map(lambda qi: diff_attend(qi, [(k, v), (k_ctx, v_ctx)], lam), qb)
    return jnp.moveaxis(o, 0, 2).reshape(b, h, n, v.shape[-1])


def swiglu(x, w1, w3, w2):
    return (jax.nn.silu(x @ w1) * (x @ w3)) @ w2


def moe_swiglu(x, router, w1, w3, w2):
    shp = x.shape
    xt = x.reshape(-1, shp[-1])
    logits = (xt @ router).astype(jnp.float32)
    top_v, top_i = lax.top_k(logits, TOP_K)
    top_w = jax.nn.softmax(top_v, axis=-1)
    gates = jnp.sum(jax.nn.one_hot(top_i, N_EXPERTS, dtype=jnp.float32) * top_w[..., None], axis=1)
    gates = gates.astype(x.dtype)
    out = gates[:, 0:1] * swiglu(xt, w1[0], w3[0], w2[0])
    for e in range(1, N_EXPERTS):
        out = out + gates[:, e:e + 1] * swiglu(xt, w1[e], w3[e], w2[e])
    return out.reshape(shp)


def even_mixer(h_lat, h_ctx, w_in, conv_w, q_g, k_g, rpb, w_out, need_ctx):
    def query_side(p):
        gb, gc, u, q = jnp.split(p, [CONV_CH, 2 * CONV_CH, 3 * CONV_CH], -1)
        y_conv = gb * dwconv3(gc * u, conv_w)
        return y_conv, rms_norm(split_heads(q, NA_HEADS), q_g)

    def kv_side(p):
        k, v = jnp.split(p, 2, -1)
        return rms_norm(split_heads(k, NA_HEADS), k_g), split_heads(v, NA_HEADS)

    p_lat = h_lat @ w_in
    yc_lat, q_lat = query_side(p_lat[..., :EV_Q])
    k_lat, v_lat = kv_side(p_lat[..., EV_Q:])
    p_ctx = h_ctx @ (w_in if need_ctx else w_in[:, EV_Q:])
    k_ctx, v_ctx = kv_side(p_ctx[..., -EV_KV:])
    y_na = merge_heads(neighbourhood_attention(q_lat, k_lat, v_lat, k_ctx, v_ctx, rpb))
    y_lat = jnp.concatenate([yc_lat, y_na], -1) @ w_out
    y_ctx = None
    if need_ctx:
        yc_ctx, q_ctx = query_side(p_ctx[..., :EV_Q])
        y_na_ctx = merge_heads(dense_attention(q_ctx, k_ctx, v_ctx))
        y_ctx = jnp.concatenate([yc_ctx, y_na_ctx], -1) @ w_out
    return y_lat, y_ctx


def odd_mixer(h_lat, h_ctx, w_in, cq_g, ck_g, sink, dq_g, dk_g, lam_q1, lam_k1, lam_q2, lam_k2,
              subln_g, w_out, lam_init, cos, sin, need_ctx):
    def diff_split(t):
        b, n, _ = t.shape
        return t.reshape(b, n, DIFF_HEADS, 2, HEAD_DIM).transpose(0, 2, 3, 1, 4)

    def query_side(p, rope):
        cq, dq = jnp.split(p, [C_Q], -1)
        cq = rms_norm(split_heads(cq, SWA_HEADS), cq_g)
        dq = rms_norm(diff_split(dq), dq_g)
        if rope:
            cq, dq = apply_rope(cq, cos, sin), apply_rope(dq, cos, sin)
        return cq, dq

    def kv_side(p, rope):
        ck, cv, dk, dv = jnp.split(p, [C_KV, 2 * C_KV, 2 * C_KV + D_QK], -1)
        ck = rms_norm(split_heads(ck, SWA_KV_HEADS), ck_g)
        dk = rms_norm(diff_split(dk), dk_g)
        if rope:
            ck, dk = apply_rope(ck, cos, sin), apply_rope(dk, cos, sin)
        return ck, split_heads(cv, SWA_KV_HEADS), dk, split_heads(dv, DIFF_HEADS)

    f32 = jnp.float32
    lam = (jnp.exp(jnp.sum(lam_q1.astype(f32) * lam_k1.astype(f32)))
           - jnp.exp(jnp.sum(lam_q2.astype(f32) * lam_k2.astype(f32))) + lam_init)

    def merge(yc, yd):
        yd = rms_norm(yd, subln_g) * (1.0 - lam_init)
        return jnp.concatenate([merge_heads(yc), merge_heads(yd)], -1) @ w_out

    p_lat = h_lat @ w_in
    cq_l, dq_l = query_side(p_lat[..., :OD_Q], True)
    ck_l, cv_l, dk_l, dv_l = kv_side(p_lat[..., OD_Q:], True)
    p_ctx = h_ctx @ (w_in if need_ctx else w_in[:, OD_Q:])
    ck_c, cv_c, dk_c, dv_c = kv_side(p_ctx[..., -OD_KV:], False)
    y_lat = merge(window_gqa(cq_l, ck_l, cv_l, ck_c, cv_c, sink),
                  diff_attention_latent(dq_l, dk_l, dv_l, dk_c, dv_c, lam))
    y_ctx = None
    if need_ctx:
        cq_c, dq_c = query_side(p_ctx[..., :OD_Q], False)
        y_ctx = merge(dense_attention(cq_c, ck_c, cv_c, sink), diff_attend(dq_c, [(dk_c, dv_c)], lam))
    return y_lat, y_ctx


def setup_inputs(seed: int = 0) -> dict:
    key = jax.random.key(seed)
    ks = iter(jax.random.split(key, 40))
    D = D_MODEL

    def nrm(shape, scale=1.0):
        return jax.random.normal(next(ks), shape, jnp.float32) * scale

    def gain(shape):
        return 1.0 + nrm(shape, 0.05)

    return {
        'x': nrm((BATCH, SEQ, D)),
        'c': nrm((BATCH, D)),
        'ctx': nrm((BATCH, CTX_LEN, D)),
        'c_ctx': nrm((D,)),
        'ada_w': nrm((DEPTH, D, 6 * D), 0.5 * D ** -0.5),
        'ada_b': nrm((DEPTH, 6 * D), 0.02),
        'norm1_g': gain((DEPTH, D)),
        'norm2_g': gain((DEPTH, D)),
        'ev_w_in': nrm((N_EVEN, D, EV_Q + EV_KV), D ** -0.5),
        'ev_conv_w': nrm((N_EVEN, CONV_W, CONV_CH), CONV_W ** -0.5),
        'ev_q_g': gain((N_EVEN, HEAD_DIM)),
        'ev_k_g': gain((N_EVEN, HEAD_DIM)),
        'ev_rpb': nrm((N_EVEN, NA_HEADS, 2 * NA_ROWS - 1, 2 * NA_COLS - 1), 0.1),
        'ev_w_out': nrm((N_EVEN, EV_OUT, D), EV_OUT ** -0.5),
        'ffn_w1': nrm((N_EVEN, D, D_FF), D ** -0.5),
        'ffn_w3': nrm((N_EVEN, D, D_FF), D ** -0.5),
        'ffn_w2': nrm((N_EVEN, D_FF, D), D_FF ** -0.5),
        'od_w_in': nrm((N_ODD, D, OD_Q + OD_KV), D ** -0.5),
        'od_cq_g': gain((N_ODD, HEAD_DIM)),
        'od_ck_g': gain((N_ODD, HEAD_DIM)),
        'od_sink': nrm((N_ODD, SWA_HEADS), 0.5),
        'od_dq_g': gain((N_ODD, HEAD_DIM)),
        'od_dk_g': gain((N_ODD, HEAD_DIM)),
        'od_lam_q1': nrm((N_ODD, HEAD_DIM), 0.1),
        'od_lam_k1': nrm((N_ODD, HEAD_DIM), 0.1),
        'od_lam_q2': nrm((N_ODD, HEAD_DIM), 0.1),
        'od_lam_k2': nrm((N_ODD, HEAD_DIM), 0.1),
        'od_subln_g': gain((N_ODD, 2 * HEAD_DIM)),
        'od_w_out': nrm((N_ODD, OD_OUT, D), OD_OUT ** -0.5),
        'moe_router': nrm((N_ODD, D, N_EXPERTS), D ** -0.5),
        'moe_w1': nrm((N_ODD, N_EXPERTS, D, D_FF_EXPERT), D ** -0.5),
        'moe_w3': nrm((N_ODD, N_EXPERTS, D, D_FF_EXPERT), D ** -0.5),
        'moe_w2': nrm((N_ODD, N_EXPERTS, D_FF_EXPERT, D), D_FF_EXPERT ** -0.5),
    }


def reference(x, c, ctx, c_ctx, ada_w, ada_b, norm1_g, norm2_g, ev_w_in, ev_conv_w, ev_q_g, ev_k_g,
              ev_rpb, ev_w_out, ffn_w1, ffn_w3, ffn_w2, od_w_in, od_cq_g, od_ck_g, od_sink, od_dq_g,
              od_dk_g, od_lam_q1, od_lam_k1, od_lam_q2, od_lam_k2, od_subln_g, od_w_out, moe_router,
              moe_w1, moe_w3, moe_w2):
    n = x.shape[1]
    cos, sin = rope_tables(n)
    h, hc = x, ctx
    s_lat = jax.nn.silu(c)
    s_ctx = jax.nn.silu(c_ctx)
    for l in range(DEPTH):
        last = l == DEPTH - 1
        i = l // 2
        mod = (s_lat @ ada_w[l] + ada_b[l])[:, None, :]
        sh1, sc1, g1, sh2, sc2, g2 = jnp.split(mod, 6, -1)
        n_mod = 2 if last else 6
        modc = jnp.split(s_ctx @ ada_w[l][:, :n_mod * D_MODEL] + ada_b[l][:n_mod * D_MODEL], n_mod)
        a_lat = rms_norm(h, norm1_g[l]) * (1 + sc1) + sh1
        a_ctx = rms_norm(hc, norm1_g[l]) * (1 + modc[1]) + modc[0]
        if l % 2 == 0:
            y, yc = even_mixer(a_lat, a_ctx, ev_w_in[i], ev_conv_w[i], ev_q_g[i], ev_k_g[i], ev_rpb[i],
                               ev_w_out[i], not last)
            ffn = lambda t: swiglu(t, ffn_w1[i], ffn_w3[i], ffn_w2[i])
        else:
            lam_init = 0.8 - 0.6 * math.exp(-0.3 * l)
            y, yc = odd_mixer(a_lat, a_ctx, od_w_in[i], od_cq_g[i], od_ck_g[i], od_sink[i], od_dq_g[i],
                              od_dk_g[i], od_lam_q1[i], od_lam_k1[i], od_lam_q2[i], od_lam_k2[i],
                              od_subln_g[i], od_w_out[i], lam_init, cos, sin, not last)
            ffn = lambda t: moe_swiglu(t, moe_router[i], moe_w1[i], moe_w3[i], moe_w2[i])
        h = h + g1 * y
        h = h + g2 * ffn(rms_norm(h, norm2_g[l]) * (1 + sc2) + sh2)
        if not last:
            hc = hc + modc[2] * yc
            hc = hc + modc[5] * ffn(rms_norm(hc, norm2_g[l]) * (1 + modc[4]) + modc[3])
    return h
```

```cpp
#include <hip/hip_runtime.h>
#include <cstdio>
#include <cstdint>

#define LAS __attribute__((address_space(3)))
#define GAS __attribute__((address_space(1)))
#define DI __device__ __forceinline__
typedef _Float16 f16;
typedef _Float16 f16x2 __attribute__((ext_vector_type(2)));
typedef _Float16 f16x4 __attribute__((ext_vector_type(4)));
typedef _Float16 f16x8 __attribute__((ext_vector_type(8)));
typedef float f32x2 __attribute__((ext_vector_type(2)));
typedef float f32x4 __attribute__((ext_vector_type(4)));
typedef float f32x16 __attribute__((ext_vector_type(16)));
typedef unsigned u32x2 __attribute__((ext_vector_type(2)));
typedef unsigned u32x4 __attribute__((ext_vector_type(4)));
typedef short s16x4 __attribute__((ext_vector_type(4)));
typedef short v4i16_t __attribute__((ext_vector_type(4)));
typedef int i32x8 __attribute__((ext_vector_type(8)));
typedef int i32x4 __attribute__((ext_vector_type(4)));

constexpr int D = 1024, NB = 4, SEQ = 8192, T = NB * SEQ, CTXL = 256, TC = NB * CTXL, MR = T + TC;
constexpr int DFF = 2816, DFE = 1408, NE = 8, EVN = 3072, ODN = 2304;
constexpr int NWAVES = 8, NTHREADS = 512;
constexpr float LOG2E = 1.4426950408889634f;
constexpr float QSCALE = 0.125f * LOG2E;
constexpr float EPS = 1e-6f;
constexpr bool F8_G4 = false;
constexpr int Q_G1E = 2;
constexpr int Q_G1O = 2, Q_G3E = 2, Q_G3G = 2;
constexpr bool F8_G4G = true;
constexpr int DFEP = 1536;

constexpr size_t MiB = 1u << 20;
constexpr size_t WS_CTL = 0, CTL_ZERO_BYTES = 1 * MiB;
constexpr size_t WS_MOD = 1 * MiB;
constexpr size_t WS_LIST = 2 * MiB;
constexpr size_t WS_GATE = 2 * MiB + 1280 * 1024;
constexpr size_t WS_RS = 4 * MiB;
constexpr size_t WS_CS_ODIN = 5 * MiB, WS_CS_F13 = 5 * MiB + 64 * 1024, WS_CS_MOE = 5 * MiB + 128 * 1024, WS_CS_EVIN = 5 * MiB + 256 * 1024;
constexpr size_t WS_W = 8 * MiB;
constexpr size_t EVW_IN = 0, EVW_OUT = 6 * MiB, EVW_13 = 8 * MiB, EVW_2 = 19 * MiB, EVW_SZ = 49 * MiB / 2;
constexpr size_t ODW_IN = 0, ODW_OUT = 9 * MiB / 2, ODS_SZ = 13 * MiB / 2;
constexpr size_t WS_WEV = WS_W, WS_WOD = WS_W + 2 * EVW_SZ, WS_MOE = WS_WOD + 2 * ODS_SZ, MOE_13 = 0, MOE_2 = 44 * MiB;
constexpr size_t WS_H16 = WS_MOE + 66 * MiB;
constexpr size_t WS_BIG = 202 * MiB;
constexpr size_t WS_K8REL = 18 * MiB;
constexpr size_t WS_V8OFF = 150 * MiB;
static_assert((size_t)MR * ODN * 2 <= WS_V8OFF && (size_t)4 * (MR / 64) * 8192 <= WS_K8REL && WS_V8OFF + 2 * WS_K8REL <= 198 * MiB, "V8 fits behind P");
constexpr size_t ROWB = (size_t)MR * D * 2;
constexpr size_t WS_R0 = 400 * MiB, WS_R1 = WS_R0 + ROWB, WS_R2 = WS_R1 + ROWB, WS_END = WS_R2 + ROWB;
static_assert(WS_H16 + ROWB <= WS_BIG, "weights + residual stream fit");
static_assert((size_t)(2 * MR + 8 * 256) * DFE * 2 <= 198 * MiB && (size_t)MR * EVN * 2 <= 198 * MiB, "BIG fits");
static_assert(WS_LIST + (size_t)8 * MR * 4 <= WS_GATE && WS_GATE + (size_t)MR * 8 <= WS_W, "tables fit");
constexpr int CW_BAR = 4096, CW_CNT = 8192;

constexpr int LDS_BYTES = 147456;
constexpr int LDSCTL_OFF = 131072;
constexpr int ATT_WSF = 69632, ATT_STG = 71680, ATT_RPB = 106496;

#define XB_TMO      128
#define XB_XCNT(j)  (256  + 64 * (j))
#define XB_XSUB(j)  (1280 + 64 * (j))
#define XB_XGEN(j)  (2304 + 64 * (j))
#define XB_TOP      3328
#define XB_TOPGEN   3392
#define XCD_BAR_WORDS 3456
#define XB_SPIN_CAP (1u << 18)

__device__ __forceinline__ unsigned xb_ld(unsigned* p)              { return __hip_atomic_load(p, __ATOMIC_RELAXED, __HIP_MEMORY_SCOPE_AGENT); }
__device__ __forceinline__ unsigned xb_add(unsigned* p, unsigned v) { return __hip_atomic_fetch_add(p, v, __ATOMIC_RELAXED, __HIP_MEMORY_SCOPE_AGENT); }
__device__ __forceinline__ unsigned xb_xcc_id() { return (unsigned)__builtin_amdgcn_s_getreg((3 << 11) | 20) & 0xFu; }
#define XB_SPIN(cond, bar) do { unsigned _sp = 0; while (cond) { __builtin_amdgcn_s_sleep(1); \
    if ((++_sp & 255u) == 0u) { if (xb_ld(&(bar)[XB_TMO])) break; if (_sp > XB_SPIN_CAP) { atomicAdd(&(bar)[XB_TMO], 1u); break; } } } } while (0)

DI int lane_id_opaque() { unsigned m = ~0u; asm volatile("" : "+s"(m)); return (int)__builtin_amdgcn_mbcnt_hi(m, __builtin_amdgcn_mbcnt_lo(m, 0u)); }
struct XcdBarrier { unsigned* bar; unsigned x; volatile LAS unsigned* st; int w; };
DI bool xb_thread0(int w) { return w == 0 && lane_id_opaque() == 0; }

__device__ __forceinline__ XcdBarrier xcd_barrier_post(unsigned* bar, volatile LAS unsigned* st, int w) {
    XcdBarrier b; b.bar = bar; b.x = xb_xcc_id(); b.st = st; b.w = w;
    if (xb_thread0(w)) (void)xb_add(&bar[XB_XCNT(b.x)], 1u);
    return b;
}
__device__ __forceinline__ void xcd_barrier_complete(unsigned* bar, unsigned x, unsigned& nloc, unsigned& nx) {
    const unsigned G = gridDim.x * gridDim.y * gridDim.z;
    unsigned sum, cnt, mine, sp = 0u;
    for (;;) {
        sum = 0u; cnt = 0u; mine = 0u;
#pragma unroll
        for (unsigned j = 0; j < 16; ++j) { const unsigned c = xb_ld(&bar[XB_XCNT(j)]); sum += c; cnt += (c > 0u) ? 1u : 0u; mine = (j == x) ? c : mine; }
        if (sum == G) break;
        __builtin_amdgcn_s_sleep(1);
        if ((++sp & 255u) == 0u) { if (xb_ld(&bar[XB_TMO])) break; if (sp > XB_SPIN_CAP) { atomicAdd(&bar[XB_TMO], 1u); break; } }
    }
    nloc = mine > 0u ? mine : 1u; nx = cnt > 0u ? cnt : 1u;
}
__device__ __forceinline__ void xcd_barrier(const XcdBarrier& b) {
    asm volatile("s_waitcnt vmcnt(0)" ::: "memory");
    __syncthreads();
    if (xb_thread0(b.w)) {
        unsigned* bar = b.bar;
        __builtin_amdgcn_s_waitcnt(0);
        unsigned nloc = b.st[0], nx = b.st[1];
        if (nloc == 0u) { xcd_barrier_complete(bar, b.x, nloc, nx); b.st[0] = nloc; b.st[1] = nx; }
        const unsigned old = xb_add(&bar[XB_XSUB(b.x)], 1u);
        const unsigned gen = old / nloc;
        if (old + 1u == (gen + 1u) * nloc) {
            __builtin_amdgcn_fence(__ATOMIC_RELEASE, "agent");
            asm volatile("s_waitcnt vmcnt(0)" ::: "memory");
            const unsigned og = xb_add(&bar[XB_TOP], 1u);
            const unsigned tg = og / nx;
            if (og + 1u == (tg + 1u) * nx) xb_add(&bar[XB_TOPGEN], 1u);
            else XB_SPIN(xb_ld(&bar[XB_TOPGEN]) == tg, bar);
            __builtin_amdgcn_fence(__ATOMIC_ACQUIRE, "agent");
            xb_add(&bar[XB_XGEN(b.x)], 1u);
            asm volatile("s_waitcnt vmcnt(0)" ::: "memory");
        } else {
            XB_SPIN(xb_ld(&bar[XB_XGEN(b.x)]) == gen, bar);
            __builtin_amdgcn_fence(__ATOMIC_ACQUIRE, "agent");
            asm volatile("s_waitcnt vmcnt(0)" ::: "memory");
        }
    }
    __syncthreads();
}

DI float wave_sum(float v) {
    v += __builtin_bit_cast(float, __builtin_amdgcn_update_dpp(0, __builtin_bit_cast(int, v), 0x128, 0xF, 0xF, false));
    v += __builtin_bit_cast(float, __builtin_amdgcn_update_dpp(0, __builtin_bit_cast(int, v), 0x124, 0xF, 0xF, false));
    v += __builtin_bit_cast(float, __builtin_amdgcn_update_dpp(0, __builtin_bit_cast(int, v), 0x122, 0xF, 0xF, false));
    v += __builtin_bit_cast(float, __builtin_amdgcn_update_dpp(0, __builtin_bit_cast(int, v), 0x121, 0xF, 0xF, false));
    { auto r = __builtin_amdgcn_permlane16_swap(__float_as_uint(v), __float_as_uint(v), false, false); v = __uint_as_float(r[0]) + __uint_as_float(r[1]); }
    { auto r = __builtin_amdgcn_permlane32_swap(__float_as_uint(v), __float_as_uint(v), false, false); v = __uint_as_float(r[0]) + __uint_as_float(r[1]); }
    return v;
}
DI float wave_max(float v) {
    v = fmaxf(v, __builtin_bit_cast(float, __builtin_amdgcn_update_dpp(0, __builtin_bit_cast(int, v), 0x128, 0xF, 0xF, false)));
    v = fmaxf(v, __builtin_bit_cast(float, __builtin_amdgcn_update_dpp(0, __builtin_bit_cast(int, v), 0x124, 0xF, 0xF, false)));
    v = fmaxf(v, __builtin_bit_cast(float, __builtin_amdgcn_update_dpp(0, __builtin_bit_cast(int, v), 0x122, 0xF, 0xF, false)));
    v = fmaxf(v, __builtin_bit_cast(float, __builtin_amdgcn_update_dpp(0, __builtin_bit_cast(int, v), 0x121, 0xF, 0xF, false)));
    { auto r = __builtin_amdgcn_permlane16_swap(__float_as_uint(v), __float_as_uint(v), false, false); v = fmaxf(__uint_as_float(r[0]), __uint_as_float(r[1])); }
    { auto r = __builtin_amdgcn_permlane32_swap(__float_as_uint(v), __float_as_uint(v), false, false); v = fmaxf(__uint_as_float(r[0]), __uint_as_float(r[1])); }
    return v;
}
DI unsigned pk4i8(float a, float b, float c, float d) {
    const unsigned ua = __float_as_uint(a + 12582912.0f), ub = __float_as_uint(b + 12582912.0f), uc = __float_as_uint(c + 12582912.0f), ud = __float_as_uint(d + 12582912.0f);
    const unsigned ab = __builtin_amdgcn_perm(ub, ua, 0x0c0c0400u), cd = __builtin_amdgcn_perm(ud, uc, 0x0c0c0400u);
    return __builtin_amdgcn_perm(cd, ab, 0x05040100u);
}
DI unsigned pk2h(float lo, float hi) { f32x2 v = {lo, hi}; f16x2 h = __builtin_convertvector(v, f16x2); return __builtin_bit_cast(unsigned, h); }
typedef __bf16 bf16x2_t __attribute__((ext_vector_type(2)));
typedef __bf16 bf16x8_t __attribute__((ext_vector_type(8)));
DI unsigned pk4f8(float a, float b, float c, float d) { int w = __builtin_bit_cast(int, a); w = __builtin_amdgcn_cvt_pk_fp8_f32(a, b, w, false); w = __builtin_amdgcn_cvt_pk_fp8_f32(c, d, w, true); return (unsigned)w; }
DI unsigned pk2bf(float lo, float hi) { f32x2 v = {lo, hi}; bf16x2_t b = __builtin_convertvector(v, bf16x2_t); return __builtin_bit_cast(unsigned, b); }
DI f32x2 unpk2h(unsigned u) { f16x2 h = __builtin_bit_cast(f16x2, u); return __builtin_convertvector(h, f32x2); }
DI float sum_xor16(float x) { auto r = __builtin_amdgcn_permlane16_swap(__float_as_uint(x), __float_as_uint(x), false, false); return __uint_as_float(r[0]) + __uint_as_float(r[1]); }
DI float sum_xor32(float x) { auto r = __builtin_amdgcn_permlane32_swap(__float_as_uint(x), __float_as_uint(x), false, false); return __uint_as_float(r[0]) + __uint_as_float(r[1]); }
DI float get_xor32(float x, bool lower_half) { auto r = __builtin_amdgcn_permlane32_swap(__float_as_uint(x), __float_as_uint(x), false, false); return lower_half ? __uint_as_float(r[1]) : __uint_as_float(r[0]); }
DI float fast_rcp(float x) { return __builtin_amdgcn_rcpf(x); }
DI float fast_exp2(float x) { return __builtin_amdgcn_exp2f(x); }
DI float silu_f(float x) { return x * fast_rcp(1.0f + fast_exp2(-x * LOG2E)); }

struct Frame {
    LAS unsigned char* lds;
    int tid, lane, wave, vcu, G;
};

DI Frame phase_frame(const Frame& F0) {
    Frame F = F0; int w = F0.wave, g = F0.G, v = F0.vcu;
    asm volatile("" : "+s"(w), "+s"(g), "+s"(v));
    int ln = lane_id_opaque();
    F.wave = w; F.lane = ln; F.tid = w * 64 + ln; F.G = g; F.vcu = v;
    return F;
}

DI void glds16s(const char* sbase, unsigned voff, unsigned lds_dst) { unsigned keep;
    asm volatile("s_mov_b32 %0, m0\n\ts_mov_b32 m0, %3\n\ts_nop 0\n\tglobal_load_lds_dwordx4 %1, %2\n\ts_mov_b32 m0, %0" : "=&s"(keep) : "v"(voff), "s"(sbase), "s"(lds_dst) : "memory"); }
DI void glds4s(const char* sbase, unsigned voff, unsigned lds_dst) { unsigned keep;
    asm volatile("s_mov_b32 %0, m0\n\ts_mov_b32 m0, %3\n\ts_nop 0\n\tglobal_load_lds_dword %1, %2\n\ts_mov_b32 m0, %0" : "=&s"(keep) : "v"(voff), "s"(sbase), "s"(lds_dst) : "memory"); }
namespace pg8 {
constexpr int BM = 256, BK = 64, HALF = 128, HTB = HALF * BK * 2, STAGE_BYTES = 8 * HTB, NXCD = 8, WGM = 8;
__host__ __device__ __forceinline__ int lds_byte(int r, int c) { const int st = (r >> 4) * 2 + (c >> 5), rr = r & 15, cc = c & 31, ob = rr * 64 + cc * 2; return st * 1024 + (ob ^ (((ob >> 9) & 1) << 5)); }
__host__ __device__ __forceinline__ void stage_rc(int b, int& R, int& C) { const int st = b / 1024, sb = b % 1024, swz = sb ^ (((sb >> 9) & 1) << 5); R = (st >> 1) * 16 + swz / 64; C = (st & 1) * 32 + (swz % 64) / 2; }
__host__ __device__ __forceinline__ int perm32(int rho) { const int n = rho >> 4, i = rho & 15; return 8 * (i >> 2) + 4 * n + (i & 3); }

struct Unit { int pm, pn, ex, i0, cnt; };

DI int xcd_remap(int wgid, int nwg) { const int q = nwg / NXCD, r = nwg % NXCD, xcd = wgid % NXCD, off = wgid / NXCD; return (xcd < r ? xcd * (q + 1) : r * (q + 1) + (xcd - r) * q) + off; }

struct StaticOrder {
    static constexpr bool GATHER = false;
    int nM, nN, nwg, G, c, K;
    DI void init(int M, int N, int K_, int G_, int c_) { nM = M / BM; nN = N / BM; nwg = nM * nN; G = G_; c = c_; K = K_; }
    DI bool next(int i, Unit& u) const {
        const long L = (long)i * G + c; if (L >= nwg) return false;
        const int wgid = xcd_remap((int)L, nwg);
        const int nig = WGM * nN, gid = wgid / nig, fm = gid * WGM, gsz = (nM - fm) < WGM ? (nM - fm) : WGM;
        u.pm = fm + ((wgid % nig) % gsz); u.pn = (wgid % nig) / gsz; u.ex = 0; u.i0 = 0; u.cnt = 0; return true;
    }
    DI size_t b_off(const Unit& u) const { return (size_t)u.pn * (size_t)(BM * 2) * K; }
    DI int a_row(const Unit&, int) const { return 0; }
    DI const int* a_ptr(const Unit&, int) const { return nullptr; }
    DI int Nper_() const { return 0; }
};
template <bool GATHER_>
struct GroupOrder {
    static constexpr bool GATHER = GATHER_;
    LAS const int* tab;
    int nN, nwg, G, c, K, Nper; const int* list;
    DI void init(const unsigned* cnt, LAS int* tab_, int Nper_, int K_, int G_, int c_, const int* list_, int w) {
        if (xb_thread0(w)) { int run = 0;
            for (int e = 0; e < 8; ++e) { const int ce = (int)__hip_atomic_load((unsigned*)cnt + e * 64, __ATOMIC_RELAXED, __HIP_MEMORY_SCOPE_AGENT); tab_[e] = run; tab_[16 + e] = ce; run += (ce + 255) >> 8; }
            tab_[8] = run; }
        __syncthreads();
        tab = tab_; Nper = Nper_; nN = Nper_ / BM; nwg = __builtin_amdgcn_readfirstlane(tab_[8]) * nN; G = G_; c = c_; K = K_; list = list_;
    }
    DI bool next(int i, Unit& u) const {
        const long L = (long)i * G + c; if (L >= nwg) return false;
        const int wgid = xcd_remap((int)L, nwg);
        const int pm = wgid / nN; u.pm = pm; u.pn = wgid % nN;
        int e = 0;
        for (int k = 1; k < 8; ++k) if (pm >= __builtin_amdgcn_readfirstlane(tab[k])) e = k;
        u.ex = e; u.i0 = (pm - __builtin_amdgcn_readfirstlane(tab[e])) * 256; u.cnt = __builtin_amdgcn_readfirstlane(tab[16 + e]); return true;
    }
    DI size_t b_off(const Unit& u) const { return ((size_t)u.ex * Nper + (size_t)u.pn * BM) * (size_t)K * 2; }
    DI int a_row(const Unit& u, int r) const { int idx = u.i0 + r; idx = idx < u.cnt ? idx : u.cnt - 1; return list[(size_t)u.ex * MR + idx] >> 1; }
    DI const int* a_ptr(const Unit& u, int r) const { int idx = u.i0 + r; idx = idx < u.cnt ? idx : u.cnt - 1; return list + (size_t)u.ex * MR + idx; }
    DI int Nper_() const { return Nper; }
};

struct EpiPlain {
    static constexpr bool PERM = true;
    f16* O; int ldc;
    DI void operator()(const f32x4 (&acc)[2][2][4][2], const Unit& u, int wr, int wc, int fr, int fq) const {
        const int row0 = u.pm * BM + wr * 64 + fr, col0 = u.pn * BM + wc * 32 + 8 * fq;
#pragma unroll
        for (int ai = 0; ai < 2; ++ai)
#pragma unroll
            for (int m = 0; m < 4; ++m) { f16* rowp = O + (size_t)(row0 + ai * HALF + m * 16) * ldc + col0;
#pragma unroll
                for (int bj = 0; bj < 2; ++bj) { const f32x4 v0 = acc[ai][bj][m][0], v1 = acc[ai][bj][m][1];
                    u32x4 w; w.x = pk2h(v0[0], v0[1]); w.y = pk2h(v0[2], v0[3]); w.z = pk2h(v1[0], v1[1]); w.w = pk2h(v1[2], v1[3]);
                    *(u32x4*)(rowp + bj * HALF) = w; } }
    }
};
template <bool OUT8 = false, bool ZPAD = false> struct EpiSwiglu {
    static constexpr bool PERM = true;
    f16* O; int ldc; int npn;
    DI void operator()(const f32x4 (&acc)[2][2][4][2], const Unit& u, int wr, int wc, int fr, int fq) const {
        const int row0 = u.pm * BM + wr * 64 + fr, col0 = u.pn * HALF + wc * 32 + 8 * fq;
#pragma unroll
        for (int ai = 0; ai < 2; ++ai)
#pragma unroll
            for (int m = 0; m < 4; ++m) { f16* rowp = O + (size_t)(row0 + ai * HALF + m * 16) * ldc + col0;
                const f32x4 g0 = acc[ai][0][m][0], g1 = acc[ai][0][m][1], u0 = acc[ai][1][m][0], u1 = acc[ai][1][m][1];
                if constexpr (OUT8) { u32x2 w;
#define SWC(x) __builtin_amdgcn_fmed3f((x), -448.0f, 448.0f)
                    w.x = pk4f8(SWC(silu_f(g0[0]) * u0[0]), SWC(silu_f(g0[1]) * u0[1]), SWC(silu_f(g0[2]) * u0[2]), SWC(silu_f(g0[3]) * u0[3]));
                    w.y = pk4f8(SWC(silu_f(g1[0]) * u1[0]), SWC(silu_f(g1[1]) * u1[1]), SWC(silu_f(g1[2]) * u1[2]), SWC(silu_f(g1[3]) * u1[3]));
#undef SWC
                    *(u32x2*)((unsigned char*)O + (size_t)(row0 + ai * HALF + m * 16) * ldc + col0) = w;
                    if constexpr (ZPAD) { if (u.pn == npn - 1) { unsigned z0 = 0u; asm volatile("" : "+v"(z0)); *(u32x2*)((unsigned char*)O + (size_t)(row0 + ai * HALF + m * 16) * ldc + col0 + HALF) = (u32x2){z0, z0}; } } }
                else { u32x4 w; w.x = pk2h(silu_f(g0[0]) * u0[0], silu_f(g0[1]) * u0[1]); w.y = pk2h(silu_f(g0[2]) * u0[2], silu_f(g0[3]) * u0[3]);
                w.z = pk2h(silu_f(g1[0]) * u1[0], silu_f(g1[1]) * u1[1]); w.w = pk2h(silu_f(g1[2]) * u1[2], silu_f(g1[3]) * u1[3]);
                *(u32x4*)rowp = w; } }
    }
};
struct EpiScatter {
    static constexpr bool PERM = true;
    f16* O; const int* list;
    DI void operator()(const f32x4 (&acc)[2][2][4][2], const Unit& u, int wr, int wc, int fr, int fq) const {
        const int lr0 = wr * 64 + fr, col0 = u.pn * BM + wc * 32 + 8 * fq;
#pragma unroll
        for (int ai = 0; ai < 2; ++ai)
#pragma unroll
            for (int m = 0; m < 4; ++m) { const int idx = u.i0 + lr0 + ai * HALF + m * 16;
                if (idx < u.cnt) { const int dst = list[(size_t)u.ex * MR + idx]; f16* rowp = O + (size_t)dst * D + col0;
#pragma unroll
                    for (int bj = 0; bj < 2; ++bj) { const f32x4 v0 = acc[ai][bj][m][0], v1 = acc[ai][bj][m][1];
                        u32x4 w; w.x = pk2h(v0[0], v0[1]); w.y = pk2h(v0[2], v0[3]); w.z = pk2h(v1[0], v1[1]); w.w = pk2h(v1[2], v1[3]);
                        *(u32x4*)(rowp + bj * HALF) = w; } } }
    }
};

template <bool ODD> struct EpiHeads {
    static constexpr bool PERM = true;
    f16* O; int ldc; LAS const float* gl; unsigned char* V8;
    DI void operator()(f32x4 (&acc)[2][2][4][2], const Unit& u, int wr, int wc, int fr_, int fq_) const {
        const int ln = lane_id_opaque();
        const int fr = ln & 15, fq = ln >> 4;
        const int row0 = u.pm * BM + wr * 64 + fr, hc0 = u.pn * BM + 64 * wc;
        int gsel = -1; bool rope = false;
        if (ODD) { if (hc0 < 512) { gsel = 0; rope = true; } else if (hc0 < 1024) { gsel = 1; rope = true; } else if (hc0 < 1152) { gsel = 2; rope = true; } else if (hc0 >= 1280 && hc0 < 1792) { gsel = 3; rope = true; } }
        else { if (hc0 >= 1536 && hc0 < 2048) gsel = 0; else if (hc0 >= 2048 && hc0 < 2560) gsel = 1; }
        rope = rope && (u.pm < T / BM);
        const bool isv = ODD ? ((hc0 >= 1152 && hc0 < 1280) || hc0 >= 1792) : (hc0 >= 2560);
        if (gsel >= 0) {
            f32x4 gn[2][2];
#pragma unroll
            for (int bj = 0; bj < 2; ++bj)
#pragma unroll
                for (int n = 0; n < 2; ++n) gn[bj][n] = *(LAS const f32x4*)(gl + gsel * 64 + 32 * bj + 8 * fq + 4 * n);
#pragma unroll
            for (int ai = 0; ai < 2; ++ai)
#pragma unroll
                for (int m = 0; m < 4; ++m) {
                    float ss = 0.f;
#pragma unroll
                    for (int bj = 0; bj < 2; ++bj)
#pragma unroll
                        for (int n = 0; n < 2; ++n) { const f32x4 v = acc[ai][bj][m][n]; ss += (v[0] * v[0] + v[1] * v[1]) + (v[2] * v[2] + v[3] * v[3]); }
                    ss = sum_xor32(sum_xor16(ss));
                    const float rs = __builtin_amdgcn_rsqf(ss * (1.0f / 64.0f) + EPS);
#pragma unroll
                    for (int bj = 0; bj < 2; ++bj)
#pragma unroll
                        for (int n = 0; n < 2; ++n) acc[ai][bj][m][n] = acc[ai][bj][m][n] * rs * gn[bj][n];
                }
        }
        if (ODD) { if (rope) {
            const int fql = fq;
            float inv[8];
#pragma unroll
            for (int e = 0; e < 8; ++e) inv[e] = fast_exp2(-(float)(8 * (fql & 1) + e) * (13.287712379549449f / 16.0f)) * 0.15915494309189535f;
            const float sgn = fql < 2 ? -1.0f : 1.0f;
            const int rbase = row0;
#pragma unroll
            for (int ai = 0; ai < 2; ++ai)
#pragma unroll
                for (int m = 0; m < 4; ++m) { const int tp = (rbase + ai * HALF + m * 16) & (SEQ - 1);
#pragma unroll
                    for (int bj = 0; bj < 2; ++bj) { const float pos = (float)(bj == 0 ? (tp >> 6) : (tp & 63));
#pragma unroll
                        for (int n = 0; n < 2; ++n)
#pragma unroll
                            for (int e = 0; e < 4; ++e) { const float rev = pos * inv[4 * n + e]; const float cs = __builtin_amdgcn_cosf(rev), sn = __builtin_amdgcn_sinf(rev) * sgn;
                                const float xv = acc[ai][bj][m][n][e]; const float pv = get_xor32(xv, fql < 2); acc[ai][bj][m][n][e] = xv * cs + pv * sn; }
                        __builtin_amdgcn_sched_barrier(0); } }
        } }
        if (ODD) { if (hc0 >= 1280 && hc0 < 1792) {
            const int hh = (hc0 - 1280) >> 7, mp = ((hc0 - 1280) >> 6) & 1;
#pragma unroll
            for (int ai = 0; ai < 2; ++ai) {
                unsigned char* img = V8 + WS_K8REL + ((size_t)(hh * (MR / 64) + u.pm * 4 + wr + 2 * ai) << 13) + mp * 4096 + (fq >> 1) * 2048 + fr * 16 + 8 * (fq & 1);
#pragma unroll
                for (int m = 0; m < 4; ++m)
#pragma unroll
                    for (int bj = 0; bj < 2; ++bj) { const f32x4 v0 = acc[ai][bj][m][0], v1 = acc[ai][bj][m][1];
                        u32x2 w; w.x = pk4f8(v0[0], v0[1], v0[2], v0[3]); w.y = pk4f8(v1[0], v1[1], v1[2], v1[3]);
                        *(u32x2*)(img + bj * 1024 + m * 256) = w; }
            }
            return;
        } }
        if (ODD) { if (hc0 >= 1792) {
            const int hh = (hc0 - 1792) >> 7, cb = (hc0 - 1792) & 127;
#pragma unroll
            for (int ai = 0; ai < 2; ++ai) {
                unsigned char* img = V8 + ((size_t)(hh * (MR / 64) + u.pm * 4 + wr + 2 * ai) << 13) + ((fr >> 3) * 2 + ((fr >> 2) & 1)) * 2048 + 4 * (fr & 3) + (cb + 8 * fq) * 16;
#pragma unroll
                for (int bj = 0; bj < 2; ++bj)
#pragma unroll
                    for (int n = 0; n < 2; ++n)
#pragma unroll
                        for (int e = 0; e < 4; ++e)
                            *(unsigned*)(img + (32 * bj + 4 * n + e) * 16) = pk4f8(acc[ai][bj][0][n][e], acc[ai][bj][1][n][e], acc[ai][bj][2][n][e], acc[ai][bj][3][n][e]);
            }
            return;
        } }
#pragma unroll
        for (int ai = 0; ai < 2; ++ai)
#pragma unroll
            for (int m = 0; m < 4; ++m) { f16* rowp = O + (size_t)(row0 + ai * HALF + m * 16) * ldc + hc0 + 8 * fq;
#pragma unroll
                for (int bj = 0; bj < 2; ++bj) { const f32x4 v0 = acc[ai][bj][m][0], v1 = acc[ai][bj][m][1];
                    u32x4 w;
                    if (isv) { w.x = pk2bf(v0[0], v0[1]); w.y = pk2bf(v0[2], v0[3]); w.z = pk2bf(v1[0], v1[1]); w.w = pk2bf(v1[2], v1[3]); }
                    else { w.x = pk2h(v0[0], v0[1]); w.y = pk2h(v0[2], v0[3]); w.z = pk2h(v1[0], v1[1]); w.w = pk2h(v1[2], v1[3]); }
                    *(u32x4*)(rowp + 32 * bj) = w; } }
    }
};

struct EpiResid {
    static constexpr bool PERM = true;
    f16* H; const float* gatev;
    DI void operator()(const f32x4 (&acc)[2][2][4][2], const Unit& u, int wr, int wc, int fr, int fq) const {
        const int v = u.pm < T / BM ? (u.pm >> 5) : 4;
        const int row0 = u.pm * BM + wr * 64 + fr, col0 = u.pn * BM + wc * 32 + 8 * fq;
        const float* gv = gatev + (size_t)v * 6144 + col0;
        f32x4 g[2][2];
#pragma unroll
        for (int bj = 0; bj < 2; ++bj)
#pragma unroll
            for (int n = 0; n < 2; ++n) g[bj][n] = *(const f32x4*)(gv + bj * HALF + n * 4);
#pragma unroll
        for (int ai = 0; ai < 2; ++ai)
#pragma unroll
            for (int m = 0; m < 4; ++m) { f16* rowp = H + (size_t)(row0 + ai * HALF + m * 16) * D + col0;
#pragma unroll
                for (int bj = 0; bj < 2; ++bj) { const u32x4 hw = *(const u32x4*)(rowp + bj * HALF);
                    const f32x2 h0 = unpk2h(hw.x), h1 = unpk2h(hw.y), h2 = unpk2h(hw.z), h3 = unpk2h(hw.w);
                    const f32x4 a0 = acc[ai][bj][m][0], a1 = acc[ai][bj][m][1], g0 = g[bj][0], g1 = g[bj][1];
                    u32x4 w; w.x = pk2h(h0[0] + g0[0] * a0[0], h0[1] + g0[1] * a0[1]); w.y = pk2h(h1[0] + g0[2] * a0[2], h1[1] + g0[3] * a0[3]);
                    w.z = pk2h(h2[0] + g1[0] * a1[0], h2[1] + g1[1] * a1[1]); w.w = pk2h(h3[0] + g1[2] * a1[2], h3[1] + g1[3] * a1[3]);
                    *(u32x4*)(rowp + bj * HALF) = w; }
                if (m & 1) asm volatile("" ::: "memory"); }
    }
};

template <class Epi, class Sched, int QM = 0>
__device__ __forceinline__ void gemm_phase(LAS unsigned char* lds, const int wave_id, const f16* Aptr, const f16* Bptr, const int K, const Sched& S, const Epi& E,
                                           const float* rs = nullptr, const float* cs = nullptr) {
    constexpr bool F8 = (QM == 1);
    constexpr bool GATHER = Sched::GATHER;
    const int lane = lane_id_opaque();
    int wid = wave_id; asm volatile("" : "+s"(wid));
    const int tid = wid * 64 + lane, wr = wid >> 2, wc = wid & 3, fr = lane & 15, fq = lane >> 4;
    int nt = K / BK; asm volatile("" : "+s"(nt));
    unsigned voffAc[2][2], voffAn[2][2], voffB[2]; int Rr[2], Cc[2];
#pragma unroll
    for (int i = 0; i < 2; ++i) { int R, C; stage_rc(tid * 16 + i * 8192, R, C); const int Rb = Epi::PERM ? ((R & ~31) + perm32(R & 31)) : R; Rr[i] = R; Cc[i] = C;
        voffB[i] = (unsigned)(Rb * K + C) * 2u;
#pragma unroll
        for (int h = 0; h < 2; ++h) { voffAc[h][i] = (unsigned)((R + HALF * h) * K + C) * 2u; voffAn[h][i] = voffAc[h][i]; } }
    const size_t kstep = (size_t)(BK * 2);
    const size_t q64 = (size_t)64 * K * 2;
    const size_t hstep = (size_t)HALF * K * 2;
    const size_t tstep = 2 * hstep;
    const unsigned ldsw = (unsigned)wid * 1024u;
    const unsigned ldsa = (unsigned)(unsigned long)lds + ldsw;
    const int aoff = lds_byte(wr * 64 + fr, fq * 8), boff = lds_byte(wc * 32 + fr, fq * 8);
#define PG8_SA(b, h) (((b) * 2 + (h)) * HTB)
#define PG8_SB(b, h) ((4 + (b) * 2 + (h)) * HTB)
#define PG8_STAGE_B(bufoff, gbase) do { _Pragma("unroll") for (int _i = 0; _i < 2; ++_i) \
        glds16s((const char*)(gbase) + (size_t)_i * q64, voffB[0], ldsa + (unsigned)((bufoff) + _i * 8192)); } while (0)
#define PG8_STAGE_A(bufoff, gbase, h, NX) do { _Pragma("unroll") for (int _i = 0; _i < 2; ++_i) { \
        if constexpr (GATHER) { const unsigned _vo = (NX) ? voffAn[h][_i] : voffAc[h][_i]; glds16s((const char*)(gbase), _vo, ldsa + (unsigned)((bufoff) + _i * 8192)); } \
        else glds16s((const char*)(gbase) + (size_t)(2 * (h) + _i) * q64, voffAc[0][0], ldsa + (unsigned)((bufoff) + _i * 8192)); } } while (0)
#define PG8_LDA(dst, b, h) do { _Pragma("unroll") for (int m = 0; m < 4; ++m) _Pragma("unroll") for (int k = 0; k < 2; ++k) dst[m][k] = *(const LAS f16x8*)(lds + PG8_SA(b, h) + aoff + m * 2048 + k * 1024); } while (0)
#define PG8_LDB(dst, b, h) do { _Pragma("unroll") for (int n = 0; n < 2; ++n) _Pragma("unroll") for (int k = 0; k < 2; ++k) dst[n][k] = *(const LAS f16x8*)(lds + PG8_SB(b, h) + boff + n * 2048 + k * 1024); } while (0)
#define PG8_MMA(ai, bj, At, Bt) do { __builtin_amdgcn_s_setprio(1); \
        if constexpr (F8) { _Pragma("unroll") for (int m = 0; m < 4; ++m) _Pragma("unroll") for (int n = 0; n < 2; ++n) \
            acc[ai][bj][m][n] = __builtin_amdgcn_mfma_scale_f32_16x16x128_f8f6f4(__builtin_bit_cast(i32x8, __builtin_shufflevector(Bt[n][0], Bt[n][1], 0, 1, 2, 3, 4, 5, 6, 7, 8, 9, 10, 11, 12, 13, 14, 15)), \
                __builtin_bit_cast(i32x8, __builtin_shufflevector(At[m][0], At[m][1], 0, 1, 2, 3, 4, 5, 6, 7, 8, 9, 10, 11, 12, 13, 14, 15)), acc[ai][bj][m][n], 0, 0, 0, 0, 0, 0); } \
        else if constexpr (QM == 2) { _Pragma("unroll") for (int m = 0; m < 4; ++m) _Pragma("unroll") for (int n = 0; n < 2; ++n) _Pragma("unroll") for (int k = 0; k < 2; ++k) \
            acc[ai][bj][m][n] = __builtin_bit_cast(f32x4, __builtin_amdgcn_mfma_i32_16x16x64_i8(__builtin_bit_cast(i32x4, Bt[n][k]), __builtin_bit_cast(i32x4, At[m][k]), __builtin_bit_cast(i32x4, acc[ai][bj][m][n]), 0, 0, 0)); } \
        else { _Pragma("unroll") for (int m = 0; m < 4; ++m) _Pragma("unroll") for (int n = 0; n < 2; ++n) _Pragma("unroll") for (int k = 0; k < 2; ++k) \
            acc[ai][bj][m][n] = __builtin_amdgcn_mfma_f32_16x16x32_f16(Bt[n][k], At[m][k], acc[ai][bj][m][n], 0, 0, 0); } __builtin_amdgcn_s_setprio(0); } while (0)
#define PG8_WAIT_V(n) asm volatile("s_waitcnt vmcnt(" #n ")" ::: "memory")
#define PG8_WAIT_L(n) asm volatile("s_waitcnt lgkmcnt(" #n ")" ::: "memory")
#define PG8_BAR __builtin_amdgcn_s_barrier()
#define PG8_SCHED __builtin_amdgcn_sched_barrier(0)
    Unit cur, nxt; int ui = 0;
    if (!S.next(0, cur)) return;
    if constexpr (GATHER) {
#pragma unroll
        for (int h = 0; h < 2; ++h)
#pragma unroll
            for (int i = 0; i < 2; ++i) voffAc[h][i] = (unsigned)(S.a_row(cur, HALF * h + Rr[i]) * K + Cc[i]) * 2u;
    }
    f32x4 acc[2][2][4][2];
#pragma unroll
    for (int a = 0; a < 2; ++a)
#pragma unroll
        for (int b = 0; b < 2; ++b)
#pragma unroll
            for (int m = 0; m < 4; ++m)
#pragma unroll
                for (int n = 0; n < 2; ++n) acc[a][b][m][n] = (f32x4){0.f, 0.f, 0.f, 0.f};
    f16x8 At[4][2], B0[2][2], B1[2][2];
    const char* cA = (const char*)Aptr + (GATHER ? (size_t)0 : (size_t)cur.pm * tstep); const char* cB = (const char*)Bptr + S.b_off(cur);
    PG8_STAGE_B(PG8_SB(0, 0), cB); PG8_STAGE_B(PG8_SB(0, 1), cB + hstep); PG8_STAGE_A(PG8_SA(0, 0), cA, 0, false); PG8_STAGE_A(PG8_SA(0, 1), cA, 1, false);
    if (wr == 1) PG8_BAR;
    PG8_WAIT_V(2); PG8_BAR;
    PG8_STAGE_B(PG8_SB(1, 0), cB + kstep); PG8_STAGE_A(PG8_SA(1, 0), cA + kstep, 0, false); PG8_STAGE_B(PG8_SB(1, 1), cB + hstep + kstep);
    PG8_WAIT_V(6); PG8_BAR;
    for (;;) {
        const bool has_next = S.next(ui + 1, nxt);
        const char* nA = (has_next && !GATHER) ? (const char*)Aptr + (size_t)nxt.pm * tstep : cA; const char* nB = has_next ? (const char*)Bptr + S.b_off(nxt) : cB;
        unsigned lraw[2][2] = {{0u, 0u}, {0u, 0u}};
        if constexpr (GATHER) {
            if (has_next) {
#pragma unroll
                for (int h = 0; h < 2; ++h)
#pragma unroll
                    for (int i = 0; i < 2; ++i) { const int* lp = S.a_ptr(nxt, HALF * h + Rr[i]); asm volatile("global_load_dword %0, %1, off" : "=v"(lraw[h][i]) : "v"(lp) : "memory"); }
            }
#pragma unroll
            for (int h = 0; h < 2; ++h)
#pragma unroll
                for (int i = 0; i < 2; ++i) voffAn[h][i] = voffAc[h][i];
        }
        unsigned ltk[4] = {0u, 0u, 0u, 0u};
        for (int t = 0; t < nt; t += 2) {
            const bool last = (t == nt - 2);
            if constexpr (QM == 2) {
                if constexpr (GATHER) {
                    if (t == nt - 4 && wid == 0) {
#pragma unroll
                        for (int j = 0; j < 4; ++j) { const int* lp = S.a_ptr(cur, 64 * j + lane); asm volatile("global_load_dword %0, %1, off" : "=v"(ltk[j]) : "v"(lp) : "memory"); } }
                    if (last && wid == 0) {
#pragma unroll
                        for (int j = 0; j < 4; ++j) { unsigned lv = ltk[j]; asm volatile("" : "+v"(lv)); glds4s((const char*)rs, (lv >> 1) * 4u, (unsigned)(unsigned long)lds + (unsigned)(LDSCTL_OFF + 2048 + 256 * j)); } }
                    if (last && wid == 1) glds16s((const char*)(cs + (size_t)cur.ex * S.Nper_() + cur.pn * BM), (unsigned)lane * 16u, (unsigned)(unsigned long)lds + (unsigned)(LDSCTL_OFF + 3072));
                } else
                if (last && wid < 2) { const char* sb = (wid == 0) ? (const char*)(rs + cur.pm * BM) : (const char*)(cs + (size_t)cur.ex * S.Nper_() + cur.pn * BM);
                    glds16s(sb, (unsigned)lane * 16u, (unsigned)(unsigned long)lds + (unsigned)(LDSCTL_OFF + 2048) + (unsigned)wid * 1024u); }
            }
            if constexpr (GATHER) {
                if (t == 2 && has_next) {
#pragma unroll
                    for (int h = 0; h < 2; ++h)
#pragma unroll
                        for (int i = 0; i < 2; ++i) { unsigned lv = lraw[h][i]; asm volatile("" : "+v"(lv)); voffAn[h][i] = (unsigned)((int)(lv >> 1) * K + Cc[i]) * 2u; }
                }
            }
            const char* a1 = cA + (size_t)(t + 1) * kstep;
            const char* a2 = last ? nA : cA + (size_t)(t + 2) * kstep; const char* b2 = last ? nB : cB + (size_t)(t + 2) * kstep;
            const char* a3 = a2 + kstep; const char* b3 = b2 + kstep;
            PG8_LDB(B0, 0, 0); PG8_LDB(B1, 0, 1); PG8_SCHED; PG8_LDA(At, 0, 0); PG8_STAGE_A(PG8_SA(1, 1), a1, 1, false);
            PG8_WAIT_V(8); PG8_WAIT_L(0); PG8_BAR; PG8_MMA(0, 0, At, B0); PG8_MMA(0, 1, At, B1); PG8_BAR; PG8_SCHED;
            PG8_LDA(At, 0, 1); PG8_STAGE_B(PG8_SB(0, 0), b2); PG8_STAGE_B(PG8_SB(0, 1), b2 + hstep); PG8_STAGE_A(PG8_SA(0, 0), a2, 0, last);
            PG8_WAIT_V(8); PG8_WAIT_L(0); PG8_BAR; PG8_MMA(1, 0, At, B0); PG8_MMA(1, 1, At, B1); PG8_BAR; PG8_SCHED;
            PG8_LDB(B0, 1, 0); PG8_LDB(B1, 1, 1); PG8_SCHED; PG8_LDA(At, 1, 0); PG8_STAGE_A(PG8_SA(0, 1), a2, 1, last);
            PG8_WAIT_V(8); PG8_WAIT_L(0); PG8_BAR; PG8_MMA(0, 0, At, B0); PG8_MMA(0, 1, At, B1); PG8_BAR; PG8_SCHED;
            PG8_LDA(At, 1, 1); PG8_STAGE_B(PG8_SB(1, 0), b3); PG8_STAGE_B(PG8_SB(1, 1), b3 + hstep); PG8_STAGE_A(PG8_SA(1, 0), a3, 0, last);
            PG8_WAIT_V(8); PG8_WAIT_L(0); PG8_BAR; PG8_MMA(1, 0, At, B0); PG8_MMA(1, 1, At, B1); PG8_BAR; PG8_SCHED;
        }
        if (wr == 0) PG8_BAR;
        if constexpr (QM == 2) {
            LAS const float* sr = (LAS const float*)(lds + LDSCTL_OFF + 2048) + wr * 64 + fr;
            LAS const float* sc = (LAS const float*)(lds + LDSCTL_OFF + 3072) + wc * 32 + 8 * fq;
            f32x4 c4[4]; float r8[8];
#pragma unroll
            for (int b = 0; b < 2; ++b)
#pragma unroll
                for (int n = 0; n < 2; ++n) c4[b * 2 + n] = *(LAS const f32x4*)(sc + b * HALF + n * 4);
#pragma unroll
            for (int a = 0; a < 2; ++a)
#pragma unroll
                for (int m = 0; m < 4; ++m) r8[a * 4 + m] = sr[a * HALF + m * 16];
            asm volatile("s_waitcnt lgkmcnt(0)" ::: "memory");
#pragma unroll
            for (int a = 0; a < 2; ++a)
#pragma unroll
                for (int m = 0; m < 4; ++m) { const float r = r8[a * 4 + m];
#pragma unroll
                    for (int b = 0; b < 2; ++b)
#pragma unroll
                        for (int n = 0; n < 2; ++n) { const f32x4 c = c4[b * 2 + n]; const i32x4 iv = __builtin_bit_cast(i32x4, acc[a][b][m][n]);
                            acc[a][b][m][n] = (f32x4){(float)iv[0] * (r * c[0]), (float)iv[1] * (r * c[1]), (float)iv[2] * (r * c[2]), (float)iv[3] * (r * c[3])}; } }
        }
        E(acc, cur, wr, wc, fr, fq);
        if (!has_next) break;
#pragma unroll
        for (int a = 0; a < 2; ++a)
#pragma unroll
            for (int b = 0; b < 2; ++b)
#pragma unroll
                for (int m = 0; m < 4; ++m)
#pragma unroll
                    for (int n = 0; n < 2; ++n) acc[a][b][m][n] = (f32x4){0.f, 0.f, 0.f, 0.f};
        cur = nxt; cA = nA; cB = nB; ++ui;
        if constexpr (GATHER) {
#pragma unroll
            for (int h = 0; h < 2; ++h)
#pragma unroll
                for (int i = 0; i < 2; ++i) voffAc[h][i] = voffAn[h][i];
        }
        if (wr == 1) PG8_BAR;
    }
    PG8_WAIT_V(0);
    PG8_BAR;
#undef PG8_SA
#undef PG8_SB
#undef PG8_STAGE_A
#undef PG8_STAGE_B
#undef PG8_LDA
#undef PG8_LDB
#undef PG8_MMA
#undef PG8_WAIT_V
#undef PG8_WAIT_L
#undef PG8_BAR
#undef PG8_SCHED
}
}

struct Args {
    const float* x; const float* c; const float* ctx; const float* c_ctx; const float* ada_w; const float* ada_b; const float* norm1_g; const float* norm2_g;
    const float* ev_w_in; const float* ev_conv_w; const float* ev_q_g; const float* ev_k_g; const float* ev_rpb; const float* ev_w_out;
    const float* ffn_w1; const float* ffn_w3; const float* ffn_w2;
    const float* od_w_in; const float* od_cq_g; const float* od_ck_g; const float* od_sink; const float* od_dq_g; const float* od_dk_g;
    const float* od_lam_q1; const float* od_lam_k1; const float* od_lam_q2; const float* od_lam_k2; const float* od_subln_g; const float* od_w_out;
    const float* moe_router; const float* moe_w1; const float* moe_w3; const float* moe_w2;
    float* out; unsigned char* ws;
};

template <bool F8>
DI void p0_transpose_item(const float* W, int K, int N, unsigned char* WT, int map, LAS float* scr, int item, int lane, int pitch) {
    const int nblk = N / 32, kb = item / nblk, nb = item % nblk, k0 = 64 * kb, n0 = 32 * nb;
    const int d0 = (map == 0) ? n0 : (map == 3) ? ((n0 >> 8) * 256 + ((n0 >> 5) & 1) * 128 + ((n0 >> 6) & 3) * 32) : ((n0 >> 7) * 256 + (map - 1) * 128 + (n0 & 127));
    float tv[32];
#pragma unroll
    for (int i = 0; i < 32; ++i) tv[i] = W[(size_t)(k0 + 2 * i + (lane >> 5)) * N + n0 + (lane & 31)];
#pragma unroll
    for (int i = 0; i < 32; ++i) scr[(2 * i + (lane >> 5)) * 33 + (lane & 31)] = tv[i];
    asm volatile("s_waitcnt lgkmcnt(0)" ::: "memory");
    const int c = lane & 7;
#pragma unroll
    for (int j = 0; j < 4; ++j) { const int n = (lane >> 3) + 8 * j; const LAS float* s = scr + (8 * c) * 33 + n;
        if constexpr (F8) { u32x2 o; o.x = pk4f8(s[0 * 33], s[1 * 33], s[2 * 33], s[3 * 33]); o.y = pk4f8(s[4 * 33], s[5 * 33], s[6 * 33], s[7 * 33]); *(u32x2*)(WT + (size_t)(d0 + n) * pitch + k0 + 8 * c) = o; }
        else { u32x4 o; o.x = pk2h(s[0 * 33], s[1 * 33]); o.y = pk2h(s[2 * 33], s[3 * 33]); o.z = pk2h(s[4 * 33], s[5 * 33]); o.w = pk2h(s[6 * 33], s[7 * 33]);
            *(u32x4*)((f16*)WT + (size_t)(d0 + n) * pitch + k0 + 8 * c) = o; } }
    asm volatile("s_waitcnt lgkmcnt(0)" ::: "memory");
}
template <bool F8 = false>
DI void p0_convert(Frame& F, const float* W, int nmat, int K, int N, unsigned char* dst, size_t dst_stride, int map, LAS float* scr, int pitch = 0) {
    if (pitch == 0) pitch = K;
    const int gw = F.vcu * NWAVES + F.wave, NGW = F.G * NWAVES;
    const int ipm = (K / 64) * (N / 32), total = ipm * nmat;
    for (int it = gw; it < total; it += NGW) { const int m = it / ipm, r = it - m * ipm;
        p0_transpose_item<F8>(W + (size_t)m * K * N, K, N, dst + (size_t)m * dst_stride, map, scr, r, F.lane, pitch); }
}
DI void p0_convert_i8(Frame& F, const float* W, int nmat, int N, unsigned char* dst, size_t dst_stride, float* cs, int cs_stride, int map) {
    constexpr int K = 1024;
    LAS float* red = (LAS float*)F.lds;
    const int lane = F.lane, n = lane & 31, hf = lane >> 5, strips = N / 32;
    for (int it = F.vcu; it < nmat * strips; it += F.G) {
        const int mt = it / strips, n0 = (it - mt * strips) * 32;
        const float* Wp = W + (size_t)mt * K * N + (size_t)(128 * F.wave + 64 * hf) * N + n0 + n;
        const int d0 = (map == 0) ? n0 : (map == 3) ? ((n0 >> 8) * 256 + ((n0 >> 5) & 1) * 128 + ((n0 >> 6) & 3) * 32) : ((n0 >> 7) * 256 + (map - 1) * 128 + (n0 & 127));
        float v[64]; float mx = 0.f;
#pragma unroll
        for (int i = 0; i < 64; ++i) { v[i] = Wp[(size_t)i * N]; mx = fmaxf(mx, fabsf(v[i])); }
        { auto r = __builtin_amdgcn_permlane32_swap(__float_as_uint(mx), __float_as_uint(mx), false, false); mx = fmaxf(__uint_as_float(r[0]), __uint_as_float(r[1])); }
        if (hf == 0) red[F.wave * 32 + n] = mx;
        __syncthreads();
        float cm = 0.f;
#pragma unroll
        for (int w = 0; w < 8; ++w) cm = fmaxf(cm, red[w * 32 + n]);
        cm = fmaxf(cm, 1e-30f);
        const float inv = 127.0f / cm;
        if (F.wave == 0 && hf == 0) cs[(size_t)mt * cs_stride + d0 + n] = cm * (1.0f / 127.0f);
        unsigned char* op = dst + (size_t)mt * dst_stride + (size_t)(d0 + n) * K + 128 * F.wave + 64 * hf;
#pragma unroll
        for (int j = 0; j < 4; ++j) { u32x4 o;
            o.x = pk4i8(v[16 * j + 0] * inv, v[16 * j + 1] * inv, v[16 * j + 2] * inv, v[16 * j + 3] * inv);
            o.y = pk4i8(v[16 * j + 4] * inv, v[16 * j + 5] * inv, v[16 * j + 6] * inv, v[16 * j + 7] * inv);
            o.z = pk4i8(v[16 * j + 8] * inv, v[16 * j + 9] * inv, v[16 * j + 10] * inv, v[16 * j + 11] * inv);
            o.w = pk4i8(v[16 * j + 12] * inv, v[16 * j + 13] * inv, v[16 * j + 14] * inv, v[16 * j + 15] * inv);
            *(u32x4*)(op + 16 * j) = o; }
        __syncthreads();
    }
}
DI void moe_convert(const Frame& F0, const float* w1, const float* w3, const float* w2, unsigned char* wsb, int i, int parts) {
    Frame F = phase_frame(F0);
    LAS float* scr = (LAS float*)(F.lds + F.wave * 8448);
    if constexpr (Q_G3G == 2) { if (parts & 1) p0_convert_i8(F, w1 + (size_t)i * NE * D * DFE, NE, DFE, wsb + WS_MOE + MOE_13, (size_t)2 * DFE * D, (float*)(wsb + WS_CS_MOE), 2 * DFE, 1);
                                if (parts & 2) p0_convert_i8(F, w3 + (size_t)i * NE * D * DFE, NE, DFE, wsb + WS_MOE + MOE_13, (size_t)2 * DFE * D, (float*)(wsb + WS_CS_MOE), 2 * DFE, 2); }
    else { if (parts & 1) p0_convert(F, w1 + (size_t)i * NE * D * DFE, NE, D, DFE, wsb + WS_MOE + MOE_13, (size_t)2 * DFE * D * 2, 1, scr);
           if (parts & 2) p0_convert(F, w3 + (size_t)i * NE * D * DFE, NE, D, DFE, wsb + WS_MOE + MOE_13, (size_t)2 * DFE * D * 2, 2, scr); }
    if (!(parts & 4)) return;
    if constexpr (F8_G4G) { p0_convert<true>(F, w2 + (size_t)i * NE * DFE * D, NE, DFE, D, wsb + WS_MOE + MOE_2, (size_t)D * DFEP, 0, scr, DFEP);
        unsigned z0 = 0u; asm volatile("" : "+v"(z0));
        for (int j = (F.vcu * NTHREADS + F.tid); j < NE * D * 8; j += F.G * NTHREADS) *(u32x4*)(wsb + WS_MOE + MOE_2 + (size_t)(j >> 3) * DFEP + DFE + 16 * (j & 7)) = (u32x4){z0, z0, z0, z0}; }
    else p0_convert(F, w2 + (size_t)i * NE * DFE * D, NE, DFE, D, wsb + WS_MOE + MOE_2, (size_t)D * DFE * 2, 0, scr);
}
DI void conv_even_layer(const Frame& F0, const float* w_in, const float* w_out, const float* f1, const float* f3, const float* f2, unsigned char* wsb, int i) {
    Frame F = phase_frame(F0);
    LAS float* scr = (LAS float*)(F.lds + F.wave * 8448);
    unsigned char* wl = wsb + WS_WEV + (size_t)i * EVW_SZ;
    if constexpr (Q_G1E == 2) p0_convert_i8(F, w_in + (size_t)i * D * EVN, 1, EVN, wl + EVW_IN, EVW_SZ, (float*)(wsb + WS_CS_EVIN) + (size_t)i * EVN, EVN, 3);
    else p0_convert(F, w_in + (size_t)i * D * EVN, 1, D, EVN, wl + EVW_IN, EVW_SZ, 3, scr);
    p0_convert(F, w_out + (size_t)i * D * D, 1, D, D, wl + EVW_OUT, EVW_SZ, 0, scr);
    if constexpr (Q_G3E == 2) { p0_convert_i8(F, f1 + (size_t)i * D * DFF, 1, DFF, wl + EVW_13, EVW_SZ, (float*)(wsb + WS_CS_F13) + (size_t)i * 2 * DFF, 2 * DFF, 1);
                                p0_convert_i8(F, f3 + (size_t)i * D * DFF, 1, DFF, wl + EVW_13, EVW_SZ, (float*)(wsb + WS_CS_F13) + (size_t)i * 2 * DFF, 2 * DFF, 2); }
    else { p0_convert(F, f1 + (size_t)i * D * DFF, 1, D, DFF, wl + EVW_13, EVW_SZ, 1, scr); p0_convert(F, f3 + (size_t)i * D * DFF, 1, D, DFF, wl + EVW_13, EVW_SZ, 2, scr); }
    p0_convert<F8_G4>(F, f2 + (size_t)i * DFF * D, 1, DFF, D, wl + EVW_2, EVW_SZ, 0, scr);
}
DI void conv_odd_layer(const Frame& F0, const float* w_in, const float* w_out, unsigned char* wsb, int i) {
    Frame F = phase_frame(F0);
    LAS float* scr = (LAS float*)(F.lds + F.wave * 8448);
    unsigned char* wl = wsb + WS_WOD + (size_t)i * ODS_SZ;
    if constexpr (Q_G1O == 2) p0_convert_i8(F, w_in + (size_t)i * D * ODN, 1, ODN, wl + ODW_IN, ODS_SZ, (float*)(wsb + WS_CS_ODIN) + (size_t)i * ODN, ODN, 3);
    else p0_convert(F, w_in + (size_t)i * D * ODN, 1, D, ODN, wl + ODW_IN, ODS_SZ, 3, scr);
    p0_convert(F, w_out + (size_t)i * D * D, 1, D, D, wl + ODW_OUT, ODS_SZ, 0, scr);
}
DI void p0_prologue(const Frame& F0, const __attribute__((address_space(4))) Args* ap) {
    Frame F = phase_frame(F0);
    struct { const float *c, *c_ctx, *ada_w, *ada_b, *ev_w_in, *ev_w_out, *ffn_w1, *ffn_w3, *ffn_w2, *od_w_in, *od_w_out; unsigned char* ws; } a;
    a.c = ap->c; a.c_ctx = ap->c_ctx; a.ada_w = ap->ada_w; a.ada_b = ap->ada_b; a.ev_w_in = ap->ev_w_in; a.ev_w_out = ap->ev_w_out; a.ffn_w1 = ap->ffn_w1; a.ffn_w3 = ap->ffn_w3; a.ffn_w2 = ap->ffn_w2;
    a.od_w_in = ap->od_w_in; a.od_w_out = ap->od_w_out; a.ws = ap->ws;
    LAS float* scr = (LAS float*)(F.lds + F.wave * 8448);
    LAS float* sv = (LAS float*)(F.lds + 8 * 8448);
    LAS float* red = (LAS float*)(F.lds + 8 * 8448 + 20480);
    for (int i = F.tid; i < 5 * 1024; i += NTHREADS) { const float v = (i < 4096) ? a.c[i] : a.c_ctx[i - 4096]; sv[i] = silu_f(v); }
    __syncthreads();
    float* mod = (float*)(a.ws + WS_MOD);
    for (int it = F.vcu; it < 4 * 96; it += F.G) {
        const int l = it / 96, n = (it % 96) * 64 + F.lane, k0 = 128 * F.wave;
        const float* wp = a.ada_w + (size_t)l * 1024 * 6144 + (size_t)k0 * 6144 + n;
        float a0 = 0.f, a1 = 0.f, a2 = 0.f, a3 = 0.f, a4 = 0.f;
#pragma unroll 16
        for (int k = 0; k < 128; ++k) { const float w = wp[(size_t)k * 6144];
            a0 += sv[k0 + k] * w; a1 += sv[1024 + k0 + k] * w; a2 += sv[2048 + k0 + k] * w; a3 += sv[3072 + k0 + k] * w; a4 += sv[4096 + k0 + k] * w; }
        LAS float* rw = red + F.wave * 320 + F.lane;
        rw[0] = a0; rw[64] = a1; rw[128] = a2; rw[192] = a3; rw[256] = a4;
        __syncthreads();
        if (F.wave < 5) { float sum = 0.f;
#pragma unroll
            for (int w = 0; w < 8; ++w) sum += red[w * 320 + F.wave * 64 + F.lane];
            mod[(size_t)l * 5 * 6144 + (size_t)F.wave * 6144 + n] = sum + a.ada_b[l * 6144 + n]; }
        __syncthreads();
    }
    conv_even_layer(F, a.ev_w_in, a.ev_w_out, a.ffn_w1, a.ffn_w3, a.ffn_w2, a.ws, 0);
}

struct RowPassP {
    const float* xin_lat; const float* xin_ctx;
    f16* H;
    float* out32;
    const f16* ysrc; const float* gatew; const float* modg;
    int gate_chunk;
    const float* modn; int sc_chunk, sh_chunk; const float* normg;
    f16* Aout;
    const float* router; int* list; unsigned* cnt; float* gateout;
    int nrows;
    float* rscale;
};
template <int RES, bool NORM, bool ROUTE, bool STORE_H, bool IN32 = false, bool OUT32 = false, int A8 = 0>
DI void row_pass(const Frame& F0, const RowPassP& p) {
    Frame F = phase_frame(F0);
    LAS float* rt = (LAS float*)F.lds;
    LAS unsigned char* selb = F.lds + 32768;
    const int rpb_ = (p.nrows + F.G - 1) / F.G;
    const int rb0 = F.vcu * rpb_;
    if constexpr (ROUTE) {
        for (int i = F.tid; i < 8192; i += NTHREADS) rt[(i & 7) * 1024 + (i >> 3)] = p.router[i];
        __syncthreads();
    }
    const int lane = F.lane;
    int vc = -1; f32x4 gsc[4], shc[4], ggc[4];
    for (int lr = F.wave; lr < rpb_; lr += NWAVES) {
        const int row = rb0 + lr; if (row >= p.nrows) break;
        const int v = row < T ? (row >> 13) : 4;
        if (v != vc) { vc = v;
            if constexpr (NORM) { const float* scv = p.modn + (size_t)v * 6144 + p.sc_chunk * 1024; const float* shv = p.modn + (size_t)v * 6144 + p.sh_chunk * 1024;
#pragma unroll
                for (int j = 0; j < 4; ++j) { const f32x4 g = *(const f32x4*)(p.normg + 4 * lane + 256 * j); const f32x4 sc = *(const f32x4*)(scv + 4 * lane + 256 * j); gsc[j] = g * (sc + 1.0f); shc[j] = *(const f32x4*)(shv + 4 * lane + 256 * j); } }
            if constexpr (RES == 2) { const float* gv = p.modg + (size_t)v * 6144 + p.gate_chunk * 1024;
#pragma unroll
                for (int j = 0; j < 4; ++j) ggc[j] = *(const f32x4*)(gv + 4 * lane + 256 * j); }
        }
        f32x4 xv[4];
        if constexpr (IN32) { const float* hrow = row < T ? p.xin_lat + (size_t)row * D : p.xin_ctx + (size_t)(row - T) * D;
#pragma unroll
            for (int j = 0; j < 4; ++j) xv[j] = *(const f32x4*)(hrow + 4 * lane + 256 * j);
        } else {
#pragma unroll
            for (int j = 0; j < 4; ++j) { const u32x2 hh = *(const u32x2*)(p.H + (size_t)row * D + 4 * lane + 256 * j); const f32x2 a = unpk2h(hh.x), b = unpk2h(hh.y); xv[j] = (f32x4){a[0], a[1], b[0], b[1]}; }
        }
        if constexpr (RES == 2) {
            const float wa = p.gatew[2 * row], wb = p.gatew[2 * row + 1];
#pragma unroll
            for (int j = 0; j < 4; ++j) { const u32x2 ya = *(const u32x2*)(p.ysrc + (size_t)(2 * row) * D + 4 * lane + 256 * j); const u32x2 yb = *(const u32x2*)(p.ysrc + (size_t)(2 * row + 1) * D + 4 * lane + 256 * j);
                const f32x2 a0 = unpk2h(ya.x), a1 = unpk2h(ya.y), b0 = unpk2h(yb.x), b1 = unpk2h(yb.y);
                const f32x4 g = ggc[j];
                xv[j][0] += g[0] * (wa * a0[0] + wb * b0[0]); xv[j][1] += g[1] * (wa * a0[1] + wb * b0[1]); xv[j][2] += g[2] * (wa * a1[0] + wb * b1[0]); xv[j][3] += g[3] * (wa * a1[1] + wb * b1[1]); }
        }
        if constexpr (STORE_H) {
#pragma unroll
            for (int j = 0; j < 4; ++j) { u32x2 w; w.x = pk2h(xv[j][0], xv[j][1]); w.y = pk2h(xv[j][2], xv[j][3]); *(u32x2*)(p.H + (size_t)row * D + 4 * lane + 256 * j) = w; }
        }
        if constexpr (OUT32) {
#pragma unroll
            for (int j = 0; j < 4; ++j) *(f32x4*)(p.out32 + (size_t)row * D + 4 * lane + 256 * j) = xv[j];
        }
        if constexpr (NORM) {
            float ss = 0.f;
#pragma unroll
            for (int j = 0; j < 4; ++j) ss += (xv[j][0] * xv[j][0] + xv[j][1] * xv[j][1]) + (xv[j][2] * xv[j][2] + xv[j][3] * xv[j][3]);
            const float rstd = __builtin_amdgcn_rsqf(wave_sum(ss) * (1.0f / D) + EPS);
            f32x4 av[4];
            if constexpr (A8 == 2) {
                float am = 0.f;
#pragma unroll
                for (int j = 0; j < 4; ++j) { av[j] = (xv[j] * rstd) * gsc[j] + shc[j]; am = fmaxf(am, fmaxf(fmaxf(fabsf(av[j][0]), fabsf(av[j][1])), fmaxf(fabsf(av[j][2]), fabsf(av[j][3])))); }
                am = fmaxf(wave_max(am), 1e-30f);
                const float inv = 127.0f / am;
                if (lane == 0) p.rscale[row] = am * (1.0f / 127.0f);
#pragma unroll
                for (int j = 0; j < 4; ++j) *(unsigned*)((unsigned char*)p.Aout + (size_t)row * D + 4 * lane + 256 * j) = pk4i8(av[j][0] * inv, av[j][1] * inv, av[j][2] * inv, av[j][3] * inv);
            } else
#pragma unroll
            for (int j = 0; j < 4; ++j) {
                av[j] = (xv[j] * rstd) * gsc[j] + shc[j];
                if constexpr (A8 == 1) *(unsigned*)((unsigned char*)p.Aout + (size_t)row * D + 4 * lane + 256 * j) = pk4f8(av[j][0], av[j][1], av[j][2], av[j][3]);
                else { u32x2 w; w.x = pk2h(av[j][0], av[j][1]); w.y = pk2h(av[j][2], av[j][3]);
                *(u32x2*)(p.Aout + (size_t)row * D + 4 * lane + 256 * j) = w; } }
            if constexpr (ROUTE) {
                float lg[8];
#pragma unroll
                for (int e = 0; e < 8; ++e) { float s = 0.f;
#pragma unroll
                    for (int j = 0; j < 4; ++j) { const f32x4 r4 = *(const LAS f32x4*)(rt + e * 1024 + 4 * lane + 256 * j); s += (av[j][0] * r4[0] + av[j][1] * r4[1]) + (av[j][2] * r4[2] + av[j][3] * r4[3]); }
                    lg[e] = wave_sum(s); }
                int e0 = 0; float l0 = lg[0];
#pragma unroll
                for (int e = 1; e < 8; ++e) if (lg[e] > l0) { l0 = lg[e]; e0 = e; }
                int e1 = -1; float l1 = -3.0e38f;
#pragma unroll
                for (int e = 0; e < 8; ++e) if (e != e0 && lg[e] > l1) { l1 = lg[e]; e1 = e; }
                const float w1 = 1.0f / (1.0f + expf(l0 - l1)), w0 = 1.0f - w1;
                if (lane == 0) { selb[2 * lr] = (unsigned char)e0; selb[2 * lr + 1] = (unsigned char)e1; p.gateout[2 * row] = w0; p.gateout[2 * row + 1] = w1; }
            }
        }
    }
    if constexpr (ROUTE) {
        __syncthreads();
        int nloc = p.nrows - rb0; nloc = nloc < 0 ? 0 : (nloc > rpb_ ? rpb_ : nloc);
        const int nent = 2 * nloc, e = F.wave;
        int total = 0;
        for (int base = 0; base < nent; base += 64) { const int n = base + lane; const bool f = (n < nent) && (selb[n] == (unsigned char)e); total += __popcll(__ballot(f)); }
        int gbase = 0;
        if (lane == 0 && total > 0) gbase = (int)__hip_atomic_fetch_add(p.cnt + e * 64, (unsigned)total, __ATOMIC_RELAXED, __HIP_MEMORY_SCOPE_AGENT);
        gbase = __builtin_amdgcn_readfirstlane(gbase);
        int run = 0;
        for (int base = 0; base < nent; base += 64) { const int n = base + lane; const bool f = (n < nent) && (selb[n] == (unsigned char)e);
            const unsigned long long m = __ballot(f); const int pre = __popcll(m & ((1ull << lane) - 1ull));
            if (f) p.list[(size_t)e * MR + gbase + run + pre] = (rb0 + (n >> 1)) * 2 + (n & 1);
            run += __popcll(m); }
        __syncthreads();
    }
}

DI void ld8(const f16* p, float (&v)[8]) { const u32x4 w = *(const u32x4*)p; const f32x2 a = unpk2h(w.x), b = unpk2h(w.y), c = unpk2h(w.z), d = unpk2h(w.w); v[0] = a[0]; v[1] = a[1]; v[2] = b[0]; v[3] = b[1]; v[4] = c[0]; v[5] = c[1]; v[6] = d[0]; v[7] = d[1]; }
DI void st8(f16* p, const float (&v)[8]) { u32x4 w; w.x = pk2h(v[0], v[1]); w.y = pk2h(v[2], v[3]); w.z = pk2h(v[4], v[5]); w.w = pk2h(v[6], v[7]); *(u32x4*)p = w; }
DI float seg_rstd(const float (&v)[8]) {
    float ss = 0.f;
#pragma unroll
    for (int j = 0; j < 8; ++j) ss += v[j] * v[j];
    ss += __shfl_xor(ss, 1); ss += __shfl_xor(ss, 2); ss += __shfl_xor(ss, 4);
    return 1.0f / sqrtf(ss * (1.0f / 64.0f) + EPS);
}
namespace att {
DI int crow(int r, int h) { return (r & 3) + 8 * (r >> 2) + 4 * h; }
DI f32x16 mfma32(f16x8 a, f16x8 b, f32x16 c) { return __builtin_amdgcn_mfma_f32_32x32x16_f16(a, b, c, 0, 0, 0); }
DI f32x16 mfma32b(bf16x8_t a, bf16x8_t b, f32x16 c) { return __builtin_amdgcn_mfma_f32_32x32x16_bf16(a, b, c, 0, 0, 0); }
DI f32x16 mfma64f8(i32x8 a, i32x8 b, f32x16 c) { return __builtin_amdgcn_mfma_scale_f32_32x32x64_f8f6f4(a, b, c, 0, 0, 0, 0, 0, 0); }
DI f32x16 mfma64f8_m4(i32x8 a, i32x8 b) { f32x16 d; asm volatile("v_mfma_f32_32x32x64_f8f6f4 %0, %1, %2, -4.0" : "=&v"(d) : "v"(a), "v"(b)); return d; }
DI s16x4 vtr(LAS const unsigned char* p) { return __builtin_bit_cast(s16x4, __builtin_amdgcn_ds_read_tr16_b64_v4i16((LAS v4i16_t*)p)); }

DI void glds16(const void* gsrc, unsigned lds_dst) { unsigned keep;
    asm volatile("s_mov_b32 %0, m0\n\ts_mov_b32 m0, %2\n\ts_nop 0\n\tglobal_load_lds_dwordx4 %1, off\n\ts_mov_b32 m0, %0" : "=&s"(keep) : "v"(gsrc), "s"(lds_dst) : "memory"); }
struct MaskNone { DI void apply(int, f32x16&, f32x16&, int, int) const {} };
struct MaskNA {
    int lo, rq, ch, wlo, NL; LAS const float* rpb;
    DI void apply(int t, f32x16& s0, f32x16& s1, int r, int h) const {
        if (t >= NL) return;
        const int kr = lo + t; const bool inwin = kr >= wlo && kr <= wlo + 7;
        int dr = kr - rq + 7; dr = dr < 0 ? 0 : (dr > 14 ? 14 : dr); LAS const float* tb = rpb + dr * 31;
        const int qcol = ch * 32 + r; int c0 = qcol - 8; c0 = c0 < 0 ? 0 : (c0 > 48 ? 48 : c0);
#pragma unroll
        for (int i = 0; i < 16; ++i) {
            const int k0 = crow(i, h), k1 = k0 + 32;
            { const bool ok = inwin && ((unsigned)(k0 - c0) < 16u); int dc = k0 - qcol + 15; dc = dc < 0 ? 0 : (dc > 30 ? 30 : dc); const float bv = tb[dc]; s0[i] = ok ? s0[i] + bv : -1.0e30f; }
            { const bool ok = inwin && ((unsigned)(k1 - c0) < 16u); int dc = k1 - qcol + 15; dc = dc < 0 ? 0 : (dc > 30 ? 30 : dc); const float bv = tb[dc]; s1[i] = ok ? s1[i] + bv : -1.0e30f; }
        }
    }
};
struct MaskSWA {
    int ka0, qa, NL;
    DI void apply(int t, f32x16& s0, f32x16& s1, int r, int h) const {
        if (t >= NL) return;
        const int d0 = ka0 + 64 * t - (qa + r);
#pragma unroll
        for (int i = 0; i < 16; ++i) { const int e0 = d0 + crow(i, h), e1 = e0 + 32;
            if (e0 > 128 || e0 < -128) s0[i] = -1.0e30f;
            if (e1 > 128 || e1 < -128) s1[i] = -1.0e30f; }
    }
};

#define ATT_SB() __builtin_amdgcn_sched_barrier(0)
template <int NK, int DV, class Mask, int VAR = 0>
DI void attn_core(Frame& F, const f16* P, int pitch, int qrow, int qcol, const unsigned char* K8h, const unsigned char* V8h, int kmap, int NL, int Lrow0, int Crow0,
                  float negoff, const Mask& M, f32x16 (&o)[DV / 32], f32x16& osum) {
    static_assert(DV == 128, "fp8 V image: 128 columns");
    static_assert(NK == 2, "fp8 K image: two maps");
    constexpr int NC = DV / 32, KSLOT = 8192, VSLOT = 8192, VRING = 4 * KSLOT;
    const int lane = F.lane, wid = F.wave, r = lane & 31, h = lane >> 5;
    const int NT = NL + 4;
    LAS unsigned char* lds = F.lds;
    const unsigned lds0 = (unsigned)(unsigned long)F.lds;
    i32x8 q;
    { const f16* qp = P + (size_t)(qrow + r) * pitch + qcol + 32 * h;
#pragma unroll
      for (int d0 = 0; d0 < 4; ++d0) { const u32x4 w = *(const u32x4*)(qp + 8 * d0); const f32x2 a = unpk2h(w.x), b = unpk2h(w.y), c = unpk2h(w.z), d = unpk2h(w.w);
          q[2 * d0] = (int)pk4f8(a[0], a[1], b[0], b[1]); q[2 * d0 + 1] = (int)pk4f8(c[0], c[1], d[0], d[1]); } }
#pragma unroll
    for (int c = 0; c < NC; ++c)
#pragma unroll
        for (int i = 0; i < 16; ++i) o[c][i] = 0.f;
#pragma unroll
    for (int i = 0; i < 16; ++i) osum[i] = 0.f;
    i32x8 ones;
#pragma unroll
    for (int i = 0; i < 8; ++i) { int x; asm volatile("v_mov_b32 %0, 0x38383838" : "=v"(x)); ones[i] = x; }
    const f32x16 zero16 = {-4.f, -4.f, -4.f, -4.f, -4.f, -4.f, -4.f, -4.f, -4.f, -4.f, -4.f, -4.f, -4.f, -4.f, -4.f, -4.f};
    const int koff = kmap * 4096 + (h * 64 + r) * 16;
    const unsigned char* kg = K8h + wid * 1024 + lane * 16;
    const int voff = VRING + (h * 128 + r) * 16;
    const unsigned char* vg = V8h + wid * 1024 + lane * 16;
    const char* Pb = (const char*)P;
#define ATT_TROW(j) ({ int j_ = (j) < NT ? (j) : NT - 1; (j_ < NL) ? (Lrow0 + 64 * j_) : (Crow0 + 64 * (j_ - NL)); })
#define ATT_DMA_K(j, slot) do { glds16(kg + ((size_t)(ATT_TROW(j) >> 6) << 13), (unsigned)__builtin_amdgcn_readfirstlane((int)(lds0 + (slot) * KSLOT + wid * 1024))); } while (0)
#define ATT_LDK(kb) do { const u32x4 k0_ = *(LAS const u32x4*)((kb) + koff), k1_ = *(LAS const u32x4*)((kb) + koff + 2048), k2_ = *(LAS const u32x4*)((kb) + koff + 512), k3_ = *(LAS const u32x4*)((kb) + koff + 2560); \
        kfa = __builtin_bit_cast(i32x8, __builtin_shufflevector(k0_, k1_, 0, 1, 2, 3, 4, 5, 6, 7)); kfb = __builtin_bit_cast(i32x8, __builtin_shufflevector(k2_, k3_, 0, 1, 2, 3, 4, 5, 6, 7)); } while (0)
#define ATT_DMA_V(j, slot) do { glds16(vg + ((size_t)(ATT_TROW(j) >> 6) << 13), (unsigned)__builtin_amdgcn_readfirstlane((int)(lds0 + VRING + (slot) * VSLOT + wid * 1024))); } while (0)
#define ATT_WAITV(n) asm volatile("s_waitcnt vmcnt(%0)" :: "n"(n) : "memory")
#define ATT_BARRIER() do { asm volatile("s_waitcnt lgkmcnt(0)" ::: "memory"); __builtin_amdgcn_s_barrier(); asm volatile("" ::: "memory"); } while (0)
    ATT_DMA_K(0, 0); ATT_DMA_V(0, 0); ATT_DMA_K(1, 1); ATT_DMA_V(1, 1); ATT_DMA_K(2, 2);
    ATT_WAITV(0); ATT_BARRIER();
    f32x16 c0 = zero16, c1 = zero16;
    { i32x8 kfa, kfb; ATT_LDK(lds); c0 = mfma64f8(kfa, q, c0); c1 = mfma64f8(kfb, q, c1); }
    ATT_BARRIER();
    M.apply(0, c0, c1, r, h);
#pragma unroll
    for (int i = 0; i < 12; ++i) { c0[i] = fast_exp2(c0[i]); c1[i] = fast_exp2(c1[i]); }
    f32x16 n0, n1;
#define ATT_RD(buf, c) do { va[buf][0] = *(LAS const u32x4*)(vb + (c) * 512); va[buf][1] = *(LAS const u32x4*)(vb + (c) * 512 + 4096); } while (0)
#define ATT_MM(buf, c) do { const i32x8 bfrag = __builtin_bit_cast(i32x8, __builtin_shufflevector(va[buf][0], va[buf][1], 0, 1, 2, 3, 4, 5, 6, 7)); o[c] = mfma64f8(pf, bfrag, o[c]); } while (0)
    i32x8 kfa, kfb;
    { LAS const unsigned char* kb1 = lds + KSLOT; ATT_LDK(kb1); }
#define ATT_E(x) x = fast_exp2(x)
#define ATT_STEP(CA, CB, NA, NB, tt, ISSUE, SYNC) do { \
        const int vs0 = (tt) & 3; \
        if (ISSUE) { ATT_DMA_K((tt) + 3, ((tt) + 3) & 3); ATT_DMA_V((tt) + 2, ((tt) + 2) & 3); ATT_DMA_K((tt) + 4, (tt) & 3); ATT_DMA_V((tt) + 3, ((tt) + 3) & 3); } \
        i32x8 pf; \
        LAS const unsigned char* vb = lds + voff + vs0 * VSLOT; \
        u32x4 va[2][2]; \
        ATT_RD(0, 0); ATT_RD(1, 1); \
        ATT_SB(); \
          \
        NA = mfma64f8_m4(kfa, q); ATT_SB(); \
        ATT_E(CA[12]); ATT_E(CB[12]); ATT_E(CA[13]); ATT_E(CB[13]); \
        _Pragma("unroll") for (int i = 0; i < 4; ++i) pf[i] = (int)pk4f8(CA[i], CA[8 + i], CB[i], CB[8 + i]); \
        ATT_SB(); \
        NB = mfma64f8_m4(kfb, q); ATT_SB(); \
        ATT_E(CA[14]); ATT_E(CB[14]); ATT_E(CA[15]); ATT_E(CB[15]); \
        _Pragma("unroll") for (int i = 4; i < 8; ++i) pf[i] = (int)pk4f8(CA[i], CA[8 + i], CB[i], CB[8 + i]); \
        ATT_SB(); \
        M.apply((tt) + 1, NA, NB, r, h); \
          \
        ATT_MM(0, 0); ATT_SB(); ATT_E(NA[0]); ATT_E(NA[1]); ATT_E(NA[2]); ATT_E(NA[3]); ATT_E(NA[4]); ATT_E(NA[5]); ATT_SB(); \
        ATT_RD(0, 2); ATT_SB(); \
        ATT_MM(1, 1); ATT_SB(); ATT_E(NA[6]); ATT_E(NA[7]); ATT_E(NA[8]); ATT_E(NA[9]); ATT_E(NA[10]); ATT_E(NA[11]); ATT_SB(); \
        ATT_RD(1, 3); if (!(SYNC)) { LAS const unsigned char* kb2 = lds + (((tt) + 2) & 3) * KSLOT; ATT_LDK(kb2); } ATT_SB(); \
        ATT_MM(0, 2); ATT_SB(); ATT_E(NB[0]); ATT_E(NB[1]); ATT_E(NB[2]); ATT_E(NB[3]); ATT_E(NB[4]); ATT_E(NB[5]); ATT_SB(); \
        if (SYNC) { ATT_WAITV(0); ATT_BARRIER(); { LAS const unsigned char* kb2 = lds + (((tt) + 2) & 3) * KSLOT; ATT_LDK(kb2); } ATT_SB(); } \
        ATT_MM(1, 3); ATT_SB(); ATT_E(NB[6]); ATT_E(NB[7]); ATT_E(NB[8]); ATT_SB(); \
        osum = mfma64f8(pf, ones, osum); ATT_SB(); ATT_E(NB[9]); ATT_E(NB[10]); ATT_E(NB[11]); ATT_SB(); \
    } while (0)
    int t = 0;
    for (; t + 1 < NT; t += 2) { ATT_STEP(c0, c1, n0, n1, t, true, false); ATT_STEP(n0, n1, c0, c1, t + 1, false, true); }
    if (t < NT) ATT_STEP(c0, c1, n0, n1, t, false, true);
#undef ATT_E
#undef ATT_STEP
#undef ATT_RD
#undef ATT_MM
    ATT_WAITV(0);
    ATT_BARRIER();
#undef ATT_TROW
#undef ATT_DMA_K
#undef ATT_LDK
#undef ATT_DMA_V
#undef ATT_WAITV
#undef ATT_BARRIER
}
#undef ATT_SB

template <int NK, int DV> struct TileRegsRS { u32x4 k[NK]; u32x4 v[DV / 64]; };
constexpr int KTB_RS = 64 * 144;
template <int NK, int DV> constexpr int tile_bytes_rs() { return NK * KTB_RS + DV * 128; }

template <int NK, int DV>
DI void tile_load_rs(TileRegsRS<NK, DV>& R, const f16* P, int pitch, int row0, const int (&kcol)[NK], int vcol, int wid, int lane) {
    const f16* kp = P + (size_t)(row0 + 8 * wid + (lane >> 3)) * pitch + (lane & 7) * 8;
#pragma unroll
    for (int m = 0; m < NK; ++m) R.k[m] = *(const u32x4*)(kp + kcol[m]);
#pragma unroll
    for (int i = 0; i < DV / 64; ++i) { const int pi = wid + 8 * i, c = pi >> 2, rg = pi & 3;
        R.v[i] = *(const u32x4*)(P + (size_t)(row0 + 16 * rg + (lane >> 2)) * pitch + vcol + 32 * c + 8 * (lane & 3)); }
}
template <int NK, int DV>
DI void tile_store_rs(const TileRegsRS<NK, DV>& R, LAS unsigned char* buf, int wid, int lane) {
#pragma unroll
    for (int m = 0; m < NK; ++m) *(LAS u32x4*)(buf + m * KTB_RS + (8 * wid + (lane >> 3)) * 144 + (lane & 7) * 16) = R.k[m];
#pragma unroll
    for (int i = 0; i < DV / 64; ++i) { const int pi = wid + 8 * i; *(LAS u32x4*)(buf + NK * KTB_RS + pi * 1024 + lane * 16) = R.v[i]; }
}

template <class M_> DI float rs_softmax_all(const M_& M, int t, f32x16& s0, f32x16& s1, int r, int h) {
    M.apply(t, s0, s1, r, h); float ls = 0.f;
#pragma unroll
    for (int i = 0; i < 16; ++i) { s0[i] = fast_exp2(s0[i]); s1[i] = fast_exp2(s1[i]); ls += s0[i] + s1[i]; }
    return ls; }
struct MaskNoneRS { DI bool active(int) const { return true; } DI void apply(int, f32x16&, f32x16&, int, int) const {} DI float softmax(int t, f32x16& s0, f32x16& s1, int r, int h) const { return rs_softmax_all(*this, t, s0, s1, r, h); } };
struct MaskNARS {
    int lo, rq, ch, wlo, NL; LAS const float* rpb;
    DI bool active(int t) const { if (t >= NL) return true; const int kr = lo + t; return kr >= wlo && kr <= wlo + 7; }
    DI void apply(int t, f32x16& s0, f32x16& s1, int r, int h) const {
        if (t >= NL) return;
        const int dr = lo + t - rq + 7;
        const int qcol = ch * 32 + r; int c0 = qcol - 8; c0 = c0 < 0 ? 0 : (c0 > 48 ? 48 : c0);
        LAS const float* tb = rpb + (dr * 31 + 15 + 4 * h - qcol);
#pragma unroll
        for (int i = 0; i < 16; ++i) {
            const int kc = (i & 3) + 8 * (i >> 2);
            const int k0 = kc + 4 * h, k1 = k0 + 32;
            { const bool ok = (unsigned)(k0 - c0) < 16u; const float bv = tb[kc];      s0[i] = ok ? s0[i] + bv : -1.0e30f; }
            { const bool ok = (unsigned)(k1 - c0) < 16u; const float bv = tb[kc + 32]; s1[i] = ok ? s1[i] + bv : -1.0e30f; }
        }
    }
    DI float softmax(int t, f32x16& s0, f32x16& s1, int r, int h) const {
        if (t >= NL) return rs_softmax_all(*this, t, s0, s1, r, h);
        const int dr = lo + t - rq + 7;
        const int qcol = ch * 32 + r; int c0 = qcol - 8; c0 = c0 < 0 ? 0 : (c0 > 48 ? 48 : c0);
        LAS const float* tb = rpb + (dr * 31 + 15 + 4 * h - qcol);
        float ls = 0.f;
        if (ch == 0) {
#pragma unroll
            for (int i = 0; i < 16; ++i) { const int kc = (i & 3) + 8 * (i >> 2), k0 = kc + 4 * h;
                const bool ok = (unsigned)(k0 - c0) < 16u; const float bv = tb[kc]; s0[i] = fast_exp2(ok ? s0[i] + bv : -1.0e30f); ls += s0[i]; }
#pragma unroll
            for (int i = 0; i < 4; ++i) { const int kc = (i & 3) + 8 * (i >> 2), k1 = kc + 4 * h + 32;
                const bool ok = (unsigned)(k1 - c0) < 16u; const float bv = tb[kc + 32]; s1[i] = fast_exp2(ok ? s1[i] + bv : -1.0e30f); ls += s1[i]; }
#pragma unroll
            for (int i = 4; i < 16; ++i) s1[i] = 0.f;
        } else {
#pragma unroll
            for (int i = 12; i < 16; ++i) { const int kc = (i & 3) + 8 * (i >> 2), k0 = kc + 4 * h;
                const bool ok = (unsigned)(k0 - c0) < 16u; const float bv = tb[kc]; s0[i] = fast_exp2(ok ? s0[i] + bv : -1.0e30f); ls += s0[i]; }
#pragma unroll
            for (int i = 0; i < 12; ++i) s0[i] = 0.f;
#pragma unroll
            for (int i = 0; i < 16; ++i) { const int kc = (i & 3) + 8 * (i >> 2), k1 = kc + 4 * h + 32;
                const bool ok = (unsigned)(k1 - c0) < 16u; const float bv = tb[kc + 32]; s1[i] = fast_exp2(ok ? s1[i] + bv : -1.0e30f); ls += s1[i]; }
        }
        return ls;
    }
};
struct MaskSWARS {
    int ka0, qa, NL;
    DI bool active(int t) const { if (t >= NL) return true; const int ka = ka0 + 64 * t; return (ka <= qa + 31 + 128) && (ka + 63 >= qa - 128); }
    DI void apply(int t, f32x16& s0, f32x16& s1, int r, int h) const {
        if (t >= NL) return;
        const int d0 = ka0 + 64 * t - (qa + r);
#pragma unroll
        for (int i = 0; i < 16; ++i) { const int e0 = d0 + crow(i, h), e1 = e0 + 32;
            if (e0 > 128 || e0 < -128) s0[i] = -1.0e30f;
            if (e1 > 128 || e1 < -128) s1[i] = -1.0e30f; }
    }
    DI float softmax(int t, f32x16& s0, f32x16& s1, int r, int h) const { return rs_softmax_all(*this, t, s0, s1, r, h); }
};

#define ATT_BAR_RS() do { asm volatile("s_waitcnt lgkmcnt(0)" ::: "memory"); __builtin_amdgcn_s_barrier(); asm volatile("" ::: "memory"); } while (0)
template <int NK, int DV, class Mask>
DI void attn_core_rs(Frame& F, const f16* P, int pitch, int qrow, int qcol, const int (&kcol)[NK], int vcol, int kmap, int NL, int Lrow0, int Crow0,
                  float negoff, const Mask& M, f32x16 (&o)[DV / 32], float& lsum) {
    constexpr int TB = tile_bytes_rs<NK, DV>();
    const int lane = F.lane, wid = F.wave, r = lane & 31, h = lane >> 5;
    const int NT = NL + 4;
    const bool trailing = false;
    f16x8 q[4];
    { const f16* qp = P + (size_t)(qrow + r) * pitch + qcol + 8 * h;
#pragma unroll
      for (int d0 = 0; d0 < 4; ++d0) q[d0] = *(const f16x8*)(qp + 16 * d0); }
#pragma unroll
    for (int c = 0; c < DV / 32; ++c)
#pragma unroll
        for (int i = 0; i < 16; ++i) o[c][i] = 0.f;
    lsum = 0.f;
    f32x16 init;
#pragma unroll
    for (int i = 0; i < 16; ++i) init[i] = negoff;
    TileRegsRS<NK, DV> RA, RB;
#define RS_TROW(j) (((j) < NL) ? (Lrow0 + 64 * (j)) : (Crow0 + 64 * ((j) - NL)))
    tile_load_rs<NK, DV>(RA, P, pitch, RS_TROW(0), kcol, vcol, wid, lane);
    tile_store_rs<NK, DV>(RA, F.lds, wid, lane);
    tile_load_rs<NK, DV>(RB, P, pitch, RS_TROW(1), kcol, vcol, wid, lane);
    tile_load_rs<NK, DV>(RA, P, pitch, RS_TROW(2), kcol, vcol, wid, lane);
    ATT_BAR_RS();
    const int voff = (4 * h + ((lane & 15) >> 2)) * 64 + ((lane >> 4) & 1) * 32 + (lane & 3) * 8;
    int bcur = 0, bnext = TB;
    constexpr int NC = DV / 32;
#define RS_RD(slot, ks) do { _Pragma("unroll") for (int c = 0; c < NC; ++c) { vv[slot][2 * c] = vtr(vb + c * 4096 + (ks) * 1024); vv[slot][2 * c + 1] = vtr(vb + c * 4096 + (ks) * 1024 + 512); } } while (0)
#define RS_MM(slot, ks) do { _Pragma("unroll") for (int c = 0; c < NC; ++c) { \
        const bf16x8_t bfrag = __builtin_bit_cast(bf16x8_t, __builtin_shufflevector(vv[slot][2 * c], vv[slot][2 * c + 1], 0, 1, 2, 3, 4, 5, 6, 7)); o[c] = mfma32b(pf[ks], bfrag, o[c]); } } while (0)
#define RS_SB() __builtin_amdgcn_sched_barrier(0)
#define RS_STEP(tt, RN) do { \
        LAS unsigned char* buf = F.lds + bcur; \
        if ((tt) + 1 < NT) { \
            tile_store_rs<NK, DV>(RN, F.lds + bnext, wid, lane); \
            if ((tt) + 3 < NT) tile_load_rs<NK, DV>(RN, P, pitch, RS_TROW((tt) + 3), kcol, vcol, wid, lane); \
        } \
        if (M.active(tt)) { \
            bf16x8_t pf[4]; \
            f32x16 s0 = init, s1 = init; \
            f16x8 kf[8]; \
            { LAS const unsigned char* kb = buf + kmap * KTB_RS + r * 144 + h * 16; \
              _Pragma("unroll") for (int d0 = 0; d0 < 4; ++d0) { kf[2 * d0] = *(LAS const f16x8*)(kb + d0 * 32); kf[2 * d0 + 1] = *(LAS const f16x8*)(kb + d0 * 32 + 32 * 144); } } \
            RS_SB(); \
            _Pragma("unroll") for (int d0 = 0; d0 < 4; ++d0) { s0 = mfma32(kf[2 * d0], q[d0], s0); s1 = mfma32(kf[2 * d0 + 1], q[d0], s1); } \
            lsum += M.softmax((tt), s0, s1, r, h); \
            _Pragma("unroll") for (int s_ = 0; s_ < 2; ++s_) { \
                u32x4 w0, w1; \
                w0.x = pk2bf(s0[8 * s_ + 0], s0[8 * s_ + 1]); w0.y = pk2bf(s0[8 * s_ + 2], s0[8 * s_ + 3]); w0.z = pk2bf(s0[8 * s_ + 4], s0[8 * s_ + 5]); w0.w = pk2bf(s0[8 * s_ + 6], s0[8 * s_ + 7]); \
                w1.x = pk2bf(s1[8 * s_ + 0], s1[8 * s_ + 1]); w1.y = pk2bf(s1[8 * s_ + 2], s1[8 * s_ + 3]); w1.z = pk2bf(s1[8 * s_ + 4], s1[8 * s_ + 5]); w1.w = pk2bf(s1[8 * s_ + 6], s1[8 * s_ + 7]); \
                pf[s_] = __builtin_bit_cast(bf16x8_t, w0); pf[2 + s_] = __builtin_bit_cast(bf16x8_t, w1); \
            } \
            RS_SB(); \
            LAS const unsigned char* vb = buf + NK * KTB_RS + voff; \
            s16x4 vv[2][2 * NC]; \
            RS_RD(0, 0); RS_RD(1, 1); RS_SB(); RS_MM(0, 0); RS_SB(); RS_RD(0, 2); RS_SB(); RS_MM(1, 1); RS_SB(); RS_RD(1, 3); RS_SB(); RS_MM(0, 2); RS_SB(); RS_MM(1, 3); RS_SB(); \
        } \
        ATT_BAR_RS();                                   \
        bcur = bnext; bnext = (bnext == 2 * TB) ? 0 : bnext + TB; \
    } while (0)
    { int t = 0; for (; t + 1 < NT; t += 2) { RS_STEP(t, RB); RS_STEP(t + 1, RA); } if (t < NT) RS_STEP(t, RB); }
#undef RS_STEP
#undef RS_RD
#undef RS_MM
#undef RS_SB
#undef RS_TROW
    ATT_BAR_RS();
}

DI void epi64(Frame& F, const f32x16 (&o)[2], float lsum, float extra, f16* Y, int qrow, int ycol) {
    const int lane = F.lane, wid = F.wave, r = lane & 31, h = lane >> 5;
    LAS float* wsf = (LAS float*)(F.lds + ATT_WSF) + wid * 64;
    float l = sum_xor32(lsum) + extra;
    if (h == 0) wsf[r] = l;
    float rli[16];
#pragma unroll
    for (int i = 0; i < 16; ++i) rli[i] = fast_rcp(wsf[crow(i, h)]);
    LAS f16* stg = (LAS f16*)(F.lds + ATT_STG) + wid * 2048;
#pragma unroll
    for (int i = 0; i < 16; ++i) { const int orow = crow(i, h);
#pragma unroll
        for (int c = 0; c < 2; ++c) stg[orow * 64 + c * 32 + r] = (f16)(o[c][i] * rli[i]); }
#pragma unroll
    for (int i = 0; i < 4; ++i) { const int row = i * 8 + (lane >> 3), ch = lane & 7; const u32x4 v = *(const LAS u32x4*)(stg + row * 64 + ch * 8);
        *(u32x4*)(Y + (size_t)(qrow + row) * D + ycol + ch * 8) = v; }
}
}

DI void conv_even(const Frame& F0, const f16* P, f16* Y, const float* convw  ) {
    Frame F = phase_frame(F0);
    const int gw = F.vcu * NWAVES + F.wave, NGW = F.G * NWAVES, lane = F.lane, c0 = 8 * lane;
    float w0[8], w1[8], w2[8];
#pragma unroll
    for (int j = 0; j < 8; ++j) { w0[j] = convw[c0 + j]; w1[j] = convw[512 + c0 + j]; w2[j] = convw[1024 + c0 + j]; }
    for (int row = gw; row < MR; row += NGW) {
        const f16* pr = P + (size_t)row * EVN;
        const int n = row < T ? SEQ : CTXL, tp = row < T ? (row & (SEQ - 1)) : ((row - T) & (CTXL - 1));
        float gb[8], gc[8], uu[8], gcm[8], um[8], gcp[8], up[8], y[8];
        ld8(pr + c0, gb); ld8(pr + 512 + c0, gc); ld8(pr + 1024 + c0, uu);
        if (tp > 0) { ld8(pr - EVN + 512 + c0, gcm); ld8(pr - EVN + 1024 + c0, um); } else {
#pragma unroll
            for (int j = 0; j < 8; ++j) { gcm[j] = 0.f; um[j] = 0.f; } }
        if (tp < n - 1) { ld8(pr + EVN + 512 + c0, gcp); ld8(pr + EVN + 1024 + c0, up); } else {
#pragma unroll
            for (int j = 0; j < 8; ++j) { gcp[j] = 0.f; up[j] = 0.f; } }
#pragma unroll
        for (int j = 0; j < 8; ++j) y[j] = gb[j] * (w0[j] * (gcm[j] * um[j]) + w1[j] * (gc[j] * uu[j]) + w2[j] * (gcp[j] * up[j]));
        st8(Y + (size_t)row * D + c0, y);
    }
}
DI void attn_even(const Frame& F0, const f16* P, f16* Y, const float* qg, const float* kg, const float* rpb  ) {
    Frame F = phase_frame(F0);
    using namespace att;
    const float negoff = 0.f;
    LAS float* rl = (LAS float*)(F.lds + ATT_RPB);
    for (int i = F.tid; i < 8 * 465; i += NTHREADS) rl[i] = rpb[i] * LOG2E;
    __syncthreads();
    const int w = F.wave;
    for (int u = F.vcu; u < 1024 + 32; u += F.G) {
        f32x16 o[2]; float lsum;
        int qrow, hh;
        if (u < 1024) {
            const int bh = u >> 5, j = u & 31, b = bh >> 3; hh = bh & 7;
            const int R0 = 4 * j, rq = R0 + (w >> 1), ch = w & 1;
            int lo = R0 - 4; lo = lo < 0 ? 0 : (lo > 120 ? 120 : lo);
            int hi = R0 + 3 - 4; hi = hi < 0 ? 0 : (hi > 120 ? 120 : hi); hi += 7;
            int wlo = rq - 4; wlo = wlo < 0 ? 0 : (wlo > 120 ? 120 : wlo);
            MaskNARS M; M.lo = lo; M.rq = rq; M.ch = ch; M.wlo = wlo; M.NL = hi - lo + 1; M.rpb = rl + hh * 465;
            qrow = b * SEQ + rq * 64 + ch * 32;
            const int kc[1] = {2048 + 64 * hh};
            attn_core_rs<1, 64, MaskNARS>(F, P, EVN, qrow, 1536 + 64 * hh, kc, 2560 + 64 * hh, 0, M.NL, b * SEQ + lo * 64, T + b * CTXL, negoff, M, o, lsum);
        } else {
            const int v = u - 1024, b = v >> 3; hh = v & 7;
            MaskNARS M; M.lo = 0; M.rq = 0; M.ch = 0; M.wlo = 0; M.NL = 0; M.rpb = rl;
            qrow = T + b * CTXL + 32 * w;
            const int kc[1] = {2048 + 64 * hh};
            attn_core_rs<1, 64, MaskNARS>(F, P, EVN, qrow, 1536 + 64 * hh, kc, 2560 + 64 * hh, 0, 0, 0, T + b * CTXL, negoff, M, o, lsum);
        }
        epi64(F, o, lsum, 0.f, Y, qrow, 512 + 64 * hh);
    }
}

DI void attn_odd(const Frame& F0, bool do_ctx, const f16* P, f16* Y, const float* cqg, const float* ckg, const float* sink, const float* dqg, const float* dkg,
                 const float* lq1, const float* lk1, const float* lq2, const float* lk2, const float* subg, float lam_init) {
    Frame F = phase_frame(F0);
    using namespace att;
    const int w = F.wave, lane = F.lane;
    {
        const float negoff = 0.f;
        const float lam = expf(wave_sum(lq1[lane] * lk1[lane])) - expf(wave_sum(lq2[lane] * lk2[lane])) + lam_init;
        const int map = w & 1, qg_ = w >> 1;
        for (int u = F.vcu; u < (do_ctx ? 1024 + 32 : 1024); u += F.G) {
            int b, hh, q0row, NL;
            if (u < 1024) { const int bh = u >> 6, qb = u & 63; b = bh >> 2; hh = bh & 3; q0row = b * SEQ + 128 * qb; NL = 128; }
            else { const int v = u - 1024, bh = v >> 1, qb = v & 1; b = bh >> 2; hh = bh & 3; q0row = T + b * CTXL + 128 * qb; NL = 0; }
            f32x16 o[4]; f32x16 osum;
            const int kc[2] = {1280 + 128 * hh, 1280 + 128 * hh + 64};
            MaskNone M;
            attn_core<2, 128, MaskNone>(F, P, ODN, q0row + 32 * qg_, 512 + 128 * hh + 64 * map, (const unsigned char*)P + WS_V8OFF + WS_K8REL + (size_t)hh * (MR / 64) * 8192, (const unsigned char*)P + WS_V8OFF + (size_t)hh * (MR / 64) * 8192, map, NL, b * SEQ, T + b * CTXL, negoff, M, o, osum);
            const int r = lane & 31, h = lane >> 5;
            float rli[16];
#pragma unroll
            for (int i = 0; i < 16; ++i) rli[i] = fast_rcp(osum[i]);
            LAS float* E = (LAS float*)F.lds;
            if (map == 1) {
#pragma unroll
                for (int c = 0; c < 4; ++c)
#pragma unroll
                    for (int i = 0; i < 16; ++i) E[(32 * qg_ + crow(i, h)) * 132 + 32 * c + r] = lam * o[c][i] * rli[i];
            }
            __syncthreads();
            if (map == 0) {
#pragma unroll
                for (int c = 0; c < 4; ++c)
#pragma unroll
                    for (int i = 0; i < 16; ++i) { const int idx = (32 * qg_ + crow(i, h)) * 132 + 32 * c + r; E[idx] = o[c][i] * rli[i] - E[idx]; }
            }
            __syncthreads();
            { const int qq = F.tid >> 2, part = F.tid & 3; const LAS float* er = E + qq * 132 + 32 * part;
              float v[32]; float ss = 0.f;
#pragma unroll
              for (int j = 0; j < 8; ++j) { const f32x4 x4 = *(const LAS f32x4*)(er + 4 * j); v[4 * j] = x4[0]; v[4 * j + 1] = x4[1]; v[4 * j + 2] = x4[2]; v[4 * j + 3] = x4[3]; ss += (x4[0] * x4[0] + x4[1] * x4[1]) + (x4[2] * x4[2] + x4[3] * x4[3]); }
              ss += __builtin_bit_cast(float, __builtin_amdgcn_update_dpp(0, __builtin_bit_cast(int, ss), 0xB1, 0xF, 0xF, false));
              ss += __builtin_bit_cast(float, __builtin_amdgcn_update_dpp(0, __builtin_bit_cast(int, ss), 0x4E, 0xF, 0xF, false));
              const float sc = (1.0f / sqrtf(ss * (1.0f / 128.0f) + EPS)) * (1.0f - lam_init);
              f16* yp = Y + (size_t)(q0row + qq) * D + 512 + 128 * hh + 32 * part;
#pragma unroll
              for (int j = 0; j < 4; ++j) { float ov[8];
#pragma unroll
                  for (int e = 0; e < 8; ++e) ov[e] = v[8 * j + e] * sc * subg[32 * part + 8 * j + e];
                  st8(yp + 8 * j, ov); } }
            __syncthreads();
        }
    }
    {
        const float negoff = 0.f;
        const int vshift = (F.vcu + F.G - (32 % F.G)) % F.G;
        for (int u0 = F.vcu; u0 < 1024 + F.G; u0 += F.G) {
            int u = u0; if (u0 >= 1024) { u = 1024 + vshift; if (vshift >= 32 || !do_ctx) break; }
            int b, kvh, qa, qrow, NL, tlo;
            if (u < 1024) { const int bk = u >> 7, jq = u & 127; b = bk >> 1; kvh = bk & 1; tlo = jq - 2 < 0 ? 0 : jq - 2; const int thi = jq + 2 > 127 ? 127 : jq + 2; NL = thi - tlo + 1;
                qa = 64 * jq + 32 * (w & 1); qrow = b * SEQ + qa; }
            else { const int v = u - 1024, bk = v >> 2, jq = v & 3; b = bk >> 1; kvh = bk & 1; tlo = 0; NL = 0; qa = 0; qrow = T + b * CTXL + 64 * jq + 32 * (w & 1); }
            const int head = kvh * 4 + (w >> 1);
            f32x16 o[2]; float lsum;
            const int kc[1] = {1024 + 64 * kvh};
            MaskSWARS M; M.ka0 = 64 * tlo; M.qa = qa; M.NL = NL;
            attn_core_rs<1, 64, MaskSWARS>(F, P, ODN, qrow, 64 * head, kc, 1152 + 64 * kvh, 0, NL, b * SEQ + 64 * tlo, T + b * CTXL, negoff, M, o, lsum);
            epi64(F, o, lsum, fast_exp2(sink[head] * LOG2E + negoff), Y, qrow, 64 * head);
        }
    }
}

__global__ void __launch_bounds__(NTHREADS, 2) fwd_kernel(Args a_unused) {
    extern __shared__ __attribute__((aligned(16))) unsigned char lds_raw[];
    __builtin_amdgcn_s_setreg((0 << 11) | (23 << 6) | 1, 1);
    Frame F;
    F.lds = (LAS unsigned char*)lds_raw;
    F.tid = threadIdx.x; F.lane = F.tid & 63; F.wave = __builtin_amdgcn_readfirstlane(F.tid >> 6);
    F.G = gridDim.x; { const int bx = blockIdx.x; F.vcu = (F.G % 8 == 0) ? (bx % 8) * (F.G / 8) + bx / 8 : bx; }
    typedef const __attribute__((address_space(4))) Args* KArgsP;
    KArgsP kap = (KArgsP)__builtin_amdgcn_kernarg_segment_ptr();
#define KA() ({ KArgsP _p = kap; asm volatile("" : "+s"(_p)); _p; })
    unsigned* ctl0 = (unsigned*)(KA()->ws + WS_CTL);
    for (int u = F.tid; u < (LDS_BYTES - LDSCTL_OFF) / 4; u += NTHREADS) ((LAS unsigned*)(F.lds + LDSCTL_OFF))[u] = 0u;
    __syncthreads();
    (void)xcd_barrier_post(ctl0 + CW_BAR, (volatile LAS unsigned*)(F.lds + LDSCTL_OFF + 64), F.wave);
#define GRID_BAR() do { XcdBarrier b_; b_.bar = (unsigned*)(ws + WS_CTL) + CW_BAR; b_.x = xb_xcc_id(); b_.st = (volatile LAS unsigned*)(F.lds + LDSCTL_OFF + 64); b_.w = F.wave; xcd_barrier(b_); } while (0)
#ifndef PM
#define PM 0xFFFFFFFFu
#endif
#ifndef DUPM
#define DUPM 0u
#endif
#define TAIL(nwg_, ...) do { const int rem_ = (nwg_) % F.G; if (bx >= rem_) { Frame Tf = F; Tf.vcu = bx - rem_; Tf.G = F.G - rem_; __VA_ARGS__; } } while (0)
#define PH(b) if constexpr ((PM >> (b)) & 1u) for (int rep_ = 0; rep_ < ((((DUPM) >> (b)) & 1u) ? 2 : 1); ++rep_, ({ if (rep_ == 1 && (((DUPM) >> (b)) & 1u)) GRID_BAR(); }))
#define ws (KA()->ws)
#define mod ((float*)(ws + WS_MOD))
#define Wlist ((int*)(ws + WS_LIST))
#define Wgate ((float*)(ws + WS_GATE))
#define H16 ((f16*)(ws + WS_H16))
#define BIG ((f16*)(ws + WS_BIG))
#define R0 ((f16*)(ws + WS_R0))
#define R1 ((f16*)(ws + WS_R1))
#define R2 ((f16*)(ws + WS_R2))
#define bx ((int)blockIdx.x)

    PH(0) p0_prologue(F, KA());
    GRID_BAR();

    for (int lp = 0; lp < 2; ++lp) {
        {
            const int l = 2 * lp;
            const float* modl = mod + (size_t)l * 5 * 6144;
            const unsigned char* wl = ws + WS_WEV + (size_t)lp * EVW_SZ;
            PH(1) { RowPassP p{}; p.H = H16; p.modn = modl; p.sc_chunk = 1; p.sh_chunk = 0; p.normg = KA()->norm1_g + l * D; p.Aout = R2; p.nrows = MR; p.rscale = (float*)(ws + WS_RS);
              if (lp == 0) { p.xin_lat = KA()->x; p.xin_ctx = KA()->ctx; row_pass<0, true, false, true, true, false, Q_G1E>(F, p); }
              else { p.ysrc = R0; p.gatew = Wgate; p.modg = mod + (size_t)(l - 1) * 5 * 6144; p.gate_chunk = 5; row_pass<2, true, false, true, false, false, Q_G1E>(F, p); } }
            GRID_BAR();
            PH(2) { LAS float* gl = (LAS float*)(F.lds + LDSCTL_OFF + 512); const int tid_ = phase_frame(F).tid;
              if (tid_ < 128) gl[tid_] = tid_ < 64 ? KA()->ev_q_g[lp * 64 + tid_] * QSCALE : KA()->ev_k_g[lp * 64 + tid_ - 64];
              __syncthreads();
              constexpr int KK = Q_G1E ? D / 2 : D; pg8::StaticOrder S; S.init(MR, EVN, KK, F.G, bx); pg8::EpiHeads<false> E{BIG, EVN, gl, nullptr};
              pg8::gemm_phase<pg8::EpiHeads<false>, pg8::StaticOrder, Q_G1E>(F.lds, F.wave, R2, (const f16*)(wl + EVW_IN), KK, S, E, (const float*)(ws + WS_RS), (const float*)(ws + WS_CS_EVIN) + (size_t)lp * EVN); }
            GRID_BAR();
            PH(3) conv_even(F, BIG, R0, KA()->ev_conv_w + lp * 3 * 512);
            PH(4) attn_even(F, BIG, R0, KA()->ev_q_g + lp * 64, KA()->ev_k_g + lp * 64, KA()->ev_rpb + lp * 8 * 465);
            GRID_BAR();
            PH(5) { pg8::StaticOrder S; S.init(MR, D, D, F.G, bx); pg8::EpiResid E{H16, modl + 2 * 1024}; pg8::gemm_phase(F.lds, F.wave, R0, (const f16*)(wl + EVW_OUT), D, S, E);
              TAIL((MR / 256) * (D / 256), if (lp == 0) conv_odd_layer(Tf, KA()->od_w_in, KA()->od_w_out, ws, 0); moe_convert(Tf, KA()->moe_w1, KA()->moe_w3, KA()->moe_w2, ws, lp, 1)); }
            GRID_BAR();
            PH(6) { RowPassP p{}; p.H = H16; p.modn = modl; p.sc_chunk = 4; p.sh_chunk = 3; p.normg = KA()->norm2_g + l * D; p.Aout = R2; p.nrows = MR; p.rscale = (float*)(ws + WS_RS); row_pass<0, true, false, false, false, false, Q_G3E>(F, p); }
            GRID_BAR();
            PH(7) { constexpr int KK = Q_G3E ? D / 2 : D; pg8::StaticOrder S; S.init(MR, 2 * DFF, KK, F.G, bx); pg8::EpiSwiglu<F8_G4> E{BIG, DFF, 0};
              pg8::gemm_phase<pg8::EpiSwiglu<F8_G4>, pg8::StaticOrder, Q_G3E>(F.lds, F.wave, R2, (const f16*)(wl + EVW_13), KK, S, E, (const float*)(ws + WS_RS), (const float*)(ws + WS_CS_F13) + (size_t)lp * 2 * DFF); }
            GRID_BAR();
            PH(8) { constexpr int KK = F8_G4 ? DFF / 2 : DFF; pg8::StaticOrder S; S.init(MR, D, KK, F.G, bx); pg8::EpiResid E{H16, modl + 5 * 1024}; pg8::gemm_phase<pg8::EpiResid, pg8::StaticOrder, F8_G4>(F.lds, F.wave, BIG, (const f16*)(wl + EVW_2), KK, S, E);
              TAIL((MR / 256) * (D / 256), moe_convert(Tf, KA()->moe_w1, KA()->moe_w3, KA()->moe_w2, ws, lp, 6)); }
            GRID_BAR();
        }
        {
            const int l = 2 * lp + 1;
            const float* modl = mod + (size_t)l * 5 * 6144;
            const unsigned char* wl = ws + WS_WOD + (size_t)lp * ODS_SZ;
            unsigned* cnt = (unsigned*)(ws + WS_CTL) + CW_CNT + lp * 8 * 64;
            PH(9) { RowPassP p{}; p.H = H16; p.modn = modl; p.sc_chunk = 1; p.sh_chunk = 0; p.normg = KA()->norm1_g + l * D; p.Aout = R1; p.nrows = MR; p.rscale = (float*)(ws + WS_RS); row_pass<0, true, false, false, false, false, Q_G1O>(F, p); }
            GRID_BAR();
            PH(10) { LAS float* gl = (LAS float*)(F.lds + LDSCTL_OFF + 512); const int tid_ = phase_frame(F).tid;
              if (tid_ < 256) { const int gsel_ = tid_ >> 6, d_ = tid_ & 63; const float* gp_ = gsel_ == 0 ? KA()->od_cq_g : gsel_ == 1 ? KA()->od_dq_g : gsel_ == 2 ? KA()->od_ck_g : KA()->od_dk_g; gl[tid_] = gp_[lp * 64 + d_] * (gsel_ < 2 ? QSCALE : 1.0f); }
              __syncthreads();
              constexpr int KK = Q_G1O ? D / 2 : D; pg8::StaticOrder S; S.init(MR, ODN, KK, F.G, bx); pg8::EpiHeads<true> E{BIG, ODN, gl, (unsigned char*)BIG + WS_V8OFF};
              pg8::gemm_phase<pg8::EpiHeads<true>, pg8::StaticOrder, Q_G1O>(F.lds, F.wave, R1, (const f16*)(wl + ODW_IN), KK, S, E, (const float*)(ws + WS_RS), (const float*)(ws + WS_CS_ODIN) + (size_t)lp * ODN); }
            GRID_BAR();
            const int Mq = (lp == 1) ? T : MR;
            PH(12) attn_odd(F, lp == 0, BIG, R2, KA()->od_cq_g + lp * 64, KA()->od_ck_g + lp * 64, KA()->od_sink + lp * 8, KA()->od_dq_g + lp * 64, KA()->od_dk_g + lp * 64,
                     KA()->od_lam_q1 + lp * 64, KA()->od_lam_k1 + lp * 64, KA()->od_lam_q2 + lp * 64, KA()->od_lam_k2 + lp * 64, KA()->od_subln_g + lp * 128, 0.8f - 0.6f * expf(-0.3f * (float)l));
            GRID_BAR();
            PH(13) { pg8::StaticOrder S; S.init(Mq, D, D, F.G, bx); pg8::EpiResid E{H16, modl + 2 * 1024}; pg8::gemm_phase(F.lds, F.wave, R2, (const f16*)(wl + ODW_OUT), D, S, E);
              if (lp == 0) TAIL((Mq / 256) * (D / 256), conv_even_layer(Tf, KA()->ev_w_in, KA()->ev_w_out, KA()->ffn_w1, KA()->ffn_w3, KA()->ffn_w2, ws, 1); conv_odd_layer(Tf, KA()->od_w_in, KA()->od_w_out, ws, 1)); }
            GRID_BAR();
            PH(14) { RowPassP p{}; p.H = H16; p.modn = modl; p.sc_chunk = 4; p.sh_chunk = 3; p.normg = KA()->norm2_g + l * D; p.Aout = R1;
              p.router = KA()->moe_router + (size_t)lp * D * NE; p.list = Wlist; p.cnt = cnt; p.gateout = Wgate; p.nrows = Mq; p.rscale = (float*)(ws + WS_RS); row_pass<0, true, true, false, false, false, Q_G3G>(F, p); }
            GRID_BAR();
            PH(15) { pg8::GroupOrder<true> S; constexpr int KK = Q_G3G ? D / 2 : D; S.init(cnt, (LAS int*)(F.lds + LDSCTL_OFF + 256), 2 * DFE, KK, F.G, bx, Wlist, F.wave); pg8::EpiSwiglu<F8_G4G, F8_G4G> E{BIG, F8_G4G ? DFEP : DFE, 2 * DFE / 256};
              pg8::gemm_phase<pg8::EpiSwiglu<F8_G4G, F8_G4G>, pg8::GroupOrder<true>, Q_G3G>(F.lds, F.wave, R1, (const f16*)(ws + WS_MOE + MOE_13), KK, S, E, (const float*)(ws + WS_RS), (const float*)(ws + WS_CS_MOE)); }
            GRID_BAR();
            PH(16) { constexpr int KK = F8_G4G ? DFEP / 2 : DFE; pg8::GroupOrder<false> S; S.init(cnt, (LAS int*)(F.lds + LDSCTL_OFF + 256), D, KK, F.G, bx, Wlist, F.wave); pg8::EpiScatter E{R0, Wlist};
              pg8::gemm_phase<pg8::EpiScatter, pg8::GroupOrder<false>, F8_G4G ? 1 : 0>(F.lds, F.wave, BIG, (const f16*)(ws + WS_MOE + MOE_2), KK, S, E); }
            GRID_BAR();
        }
    }
    PH(17) { RowPassP p{}; p.H = H16; p.out32 = KA()->out; p.ysrc = R0; p.gatew = Wgate; p.modg = mod + (size_t)3 * 5 * 6144; p.gate_chunk = 5; p.nrows = T;
      row_pass<2, false, false, false, false, true>(F, p); }
}

#undef ws
#undef mod
#undef Wlist
#undef Wgate
#undef H16
#undef BIG
#undef R0
#undef R1
#undef R2
#undef bx
extern "C" void kernel_launch(void* const* d_in, const int* in_sizes, int n_in, void* d_out, int out_size, void* d_ws, size_t ws_size, hipStream_t stream) {
    static int grid = 0;
    if (grid == 0) {
        if (n_in != 33 || out_size != T * D || ws_size < WS_END) { fprintf(stderr, "kernel_launch: unexpected shapes (n_in %d, out %d, ws %zu, need %zu)\n", n_in, out_size, ws_size, (size_t)WS_END); grid = -1; return; }
        int dev = 0, cus = 0, per_cu = 0;
        if (hipGetDevice(&dev) != hipSuccess || hipDeviceGetAttribute(&cus, hipDeviceAttributeMultiprocessorCount, dev) != hipSuccess) { grid = -1; return; }
        if (hipFuncSetAttribute((const void*)fwd_kernel, hipFuncAttributeMaxDynamicSharedMemorySize, LDS_BYTES) != hipSuccess) { grid = -1; return; }
        if (hipOccupancyMaxActiveBlocksPerMultiprocessor(&per_cu, (const void*)fwd_kernel, NTHREADS, LDS_BYTES) != hipSuccess || per_cu < 1) { fprintf(stderr, "kernel_launch: occupancy query reports %d\n", per_cu); }
        (void)hipGetLastError();
        grid = cus;
    }
    if (grid < 0) return;
    if (hipMemsetAsync((char*)d_ws + WS_CTL, 0, CTL_ZERO_BYTES, stream) != hipSuccess) return;
    Args a{};
    const float* const* in = (const float* const*)d_in;
    a.x = in[0]; a.c = in[1]; a.ctx = in[2]; a.c_ctx = in[3]; a.ada_w = in[4]; a.ada_b = in[5]; a.norm1_g = in[6]; a.norm2_g = in[7];
    a.ev_w_in = in[8]; a.ev_conv_w = in[9]; a.ev_q_g = in[10]; a.ev_k_g = in[11]; a.ev_rpb = in[12]; a.ev_w_out = in[13];
    a.ffn_w1 = in[14]; a.ffn_w3 = in[15]; a.ffn_w2 = in[16];
    a.od_w_in = in[17]; a.od_cq_g = in[18]; a.od_ck_g = in[19]; a.od_sink = in[20]; a.od_dq_g = in[21]; a.od_dk_g = in[22];
    a.od_lam_q1 = in[23]; a.od_lam_k1 = in[24]; a.od_lam_q2 = in[25]; a.od_lam_k2 = in[26]; a.od_subln_g = in[27]; a.od_w_out = in[28];
    a.moe_router = in[29]; a.moe_w1 = in[30]; a.moe_w3 = in[31]; a.moe_w2 = in[32];
    a.out = (float*)d_out; a.ws = (unsigned char*)d_ws;
    hipLaunchKernelGGL(fwd_kernel, dim3(grid), dim3(NTHREADS), LDS_BYTES, stream, a);
}
```

```cpp
#include <hip/hip_runtime.h>
#include <cstdio>
#include <cstdint>

#define LAS __attribute__((address_space(3)))
#define GAS __attribute__((address_space(1)))
#define DI __device__ __forceinline__
typedef _Float16 f16;
typedef _Float16 f16x2 __attribute__((ext_vector_type(2)));
typedef _Float16 f16x4 __attribute__((ext_vector_type(4)));
typedef _Float16 f16x8 __attribute__((ext_vector_type(8)));
typedef float f32x2 __attribute__((ext_vector_type(2)));
typedef float f32x4 __attribute__((ext_vector_type(4)));
typedef float f32x16 __attribute__((ext_vector_type(16)));
typedef unsigned u32x2 __attribute__((ext_vector_type(2)));
typedef unsigned u32x4 __attribute__((ext_vector_type(4)));
typedef short s16x4 __attribute__((ext_vector_type(4)));
typedef short v4i16_t __attribute__((ext_vector_type(4)));
typedef int i32x8 __attribute__((ext_vector_type(8)));
typedef int i32x4 __attribute__((ext_vector_type(4)));

constexpr int D = 1024, NB = 4, SEQ = 8192, T = NB * SEQ, CTXL = 256, TC = NB * CTXL, MR = T + TC;
constexpr int DFF = 2816, DFE = 1408, NE = 8, EVN = 3072, ODN = 2304;
constexpr int NWAVES = 8, NTHREADS = 512;
constexpr float LOG2E = 1.4426950408889634f;
constexpr float QSCALE = 0.125f * LOG2E;
constexpr float EPS = 1e-6f;
constexpr bool F8_G4 = true;
constexpr float W8S = 32.0f;
constexpr int Q_G1E = 2;
constexpr int Q_G1O = 2, Q_G3E = 2, Q_G3G = 2;
constexpr bool F8_G4G = true;
constexpr int DFEP = 1536;

constexpr size_t MiB = 1u << 20;
constexpr size_t WS_CTL = 0, CTL_ZERO_BYTES = 1 * MiB;
constexpr size_t WS_MOD = 1 * MiB;
constexpr size_t WS_LIST = 2 * MiB;
constexpr size_t WS_GATE = 2 * MiB + 1280 * 1024;
constexpr size_t WS_RS = 4 * MiB;
constexpr size_t WS_CS_ODIN = 5 * MiB, WS_CS_F13 = 5 * MiB + 64 * 1024, WS_CS_MOE = 5 * MiB + 128 * 1024, WS_CS_EVIN = 5 * MiB + 256 * 1024;
constexpr size_t WS_W = 8 * MiB;
constexpr size_t EVW_IN = 0, EVW_OUT = 6 * MiB, EVW_13 = 8 * MiB, EVW_2 = 19 * MiB, EVW_SZ = 49 * MiB / 2;
constexpr size_t ODW_IN = 0, ODW_OUT = 9 * MiB / 2, ODS_SZ = 13 * MiB / 2;
constexpr size_t WS_WEV = WS_W, WS_WOD = WS_W + 2 * EVW_SZ, WS_MOE = WS_WOD + 2 * ODS_SZ, MOE_13 = 0, MOE_2 = 44 * MiB;
constexpr size_t WS_PART = WS_MOE + 24 * MiB;
constexpr size_t WS_H16 = WS_MOE + 66 * MiB;
constexpr size_t WS_BIG = 202 * MiB;
constexpr size_t WS_K8REL = 18 * MiB, WS_CK8REL = 36 * MiB, WS_CV8REL = 41 * MiB;
constexpr size_t WS_V8OFF = 150 * MiB;
static_assert((size_t)MR * ODN * 2 <= WS_V8OFF && (size_t)4 * (MR / 64) * 8192 <= WS_K8REL && (size_t)2 * (MR / 64) * 4096 <= 5 * MiB && WS_V8OFF + WS_CV8REL + 5 * MiB <= 198 * MiB, "V8 fits behind P");
constexpr size_t ROWB = (size_t)MR * D * 2;
constexpr size_t WS_R0 = 400 * MiB, WS_R1 = WS_R0 + ROWB, WS_R2 = WS_R1 + ROWB, WS_END = WS_R2 + ROWB;
static_assert(WS_H16 + ROWB <= WS_BIG, "weights + residual stream fit");
static_assert((size_t)(2 * MR + 8 * 256) * DFE * 2 <= 198 * MiB && (size_t)MR * EVN * 2 <= 198 * MiB, "BIG fits");
static_assert(WS_LIST + (size_t)8 * MR * 4 <= WS_GATE && WS_GATE + (size_t)MR * 8 <= WS_W, "tables fit");
constexpr int CW_BAR = 4096, CW_CNT = 8192, CW_PAIR = 16384;

constexpr int LDS_BYTES = 147456;
constexpr int LDSCTL_OFF = 131072;
constexpr int ATT_WSF = 69632, ATT_STG = 71680, ATT_RPB = 106496;

#define XB_TMO      128
#define XB_XCNT(j)  (256  + 64 * (j))
#define XB_XSUB(j)  (1280 + 64 * (j))
#define XB_XGEN(j)  (2304 + 64 * (j))
#define XB_TOP      3328
#define XB_TOPGEN   3392
#define XCD_BAR_WORDS 3456
#define XB_SPIN_CAP (1u << 18)

__device__ __forceinline__ unsigned xb_ld(unsigned* p)              { return __hip_atomic_load(p, __ATOMIC_RELAXED, __HIP_MEMORY_SCOPE_AGENT); }
__device__ __forceinline__ unsigned xb_add(unsigned* p, unsigned v) { return __hip_atomic_fetch_add(p, v, __ATOMIC_RELAXED, __HIP_MEMORY_SCOPE_AGENT); }
__device__ __forceinline__ unsigned xb_xcc_id() { return (unsigned)__builtin_amdgcn_s_getreg((3 << 11) | 20) & 0xFu; }
#define XB_SPIN(cond, bar) do { unsigned _sp = 0; while (cond) { __builtin_amdgcn_s_sleep(1); \
    if ((++_sp & 255u) == 0u) { if (xb_ld(&(bar)[XB_TMO])) break; if (_sp > XB_SPIN_CAP) { atomicAdd(&(bar)[XB_TMO], 1u); break; } } } } while (0)

DI int lane_id_opaque() { unsigned m = ~0u; asm volatile("" : "+s"(m)); return (int)__builtin_amdgcn_mbcnt_hi(m, __builtin_amdgcn_mbcnt_lo(m, 0u)); }
struct XcdBarrier { unsigned* bar; unsigned x; volatile LAS unsigned* st; int w; };
DI bool xb_thread0(int w) { return w == 0 && lane_id_opaque() == 0; }

__device__ __forceinline__ XcdBarrier xcd_barrier_post(unsigned* bar, volatile LAS unsigned* st, int w) {
    XcdBarrier b; b.bar = bar; b.x = xb_xcc_id(); b.st = st; b.w = w;
    if (xb_thread0(w)) (void)xb_add(&bar[XB_XCNT(b.x)], 1u);
    return b;
}
__device__ __forceinline__ void xcd_barrier_complete(unsigned* bar, unsigned x, unsigned& nloc, unsigned& nx) {
    const unsigned G = gridDim.x * gridDim.y * gridDim.z;
    unsigned sum, cnt, mine, sp = 0u;
    for (;;) {
        sum = 0u; cnt = 0u; mine = 0u;
#pragma unroll
        for (unsigned j = 0; j < 16; ++j) { const unsigned c = xb_ld(&bar[XB_XCNT(j)]); sum += c; cnt += (c > 0u) ? 1u : 0u; mine = (j == x) ? c : mine; }
        if (sum == G) break;
        __builtin_amdgcn_s_sleep(1);
        if ((++sp & 255u) == 0u) { if (xb_ld(&bar[XB_TMO])) break; if (sp > XB_SPIN_CAP) { atomicAdd(&bar[XB_TMO], 1u); break; } }
    }
    nloc = mine > 0u ? mine : 1u; nx = cnt > 0u ? cnt : 1u;
}
__device__ __forceinline__ void xcd_barrier(const XcdBarrier& b) {
    asm volatile("s_waitcnt vmcnt(0)" ::: "memory");
    __syncthreads();
    if (xb_thread0(b.w)) {
        unsigned* bar = b.bar;
        __builtin_amdgcn_s_waitcnt(0);
        unsigned nloc = b.st[0], nx = b.st[1];
        if (nloc == 0u) { xcd_barrier_complete(bar, b.x, nloc, nx); b.st[0] = nloc; b.st[1] = nx; }
        const unsigned old = xb_add(&bar[XB_XSUB(b.x)], 1u);
        const unsigned gen = old / nloc;
        if (old + 1u == (gen + 1u) * nloc) {
            __builtin_amdgcn_fence(__ATOMIC_RELEASE, "agent");
            asm volatile("s_waitcnt vmcnt(0)" ::: "memory");
            const unsigned og = xb_add(&bar[XB_TOP], 1u);
            const unsigned tg = og / nx;
            if (og + 1u == (tg + 1u) * nx) xb_add(&bar[XB_TOPGEN], 1u);
            else XB_SPIN(xb_ld(&bar[XB_TOPGEN]) == tg, bar);
            __builtin_amdgcn_fence(__ATOMIC_ACQUIRE, "agent");
            xb_add(&bar[XB_XGEN(b.x)], 1u);
            asm volatile("s_waitcnt vmcnt(0)" ::: "memory");
        } else {
            XB_SPIN(xb_ld(&bar[XB_XGEN(b.x)]) == gen, bar);
            __builtin_amdgcn_fence(__ATOMIC_ACQUIRE, "agent");
            asm volatile("s_waitcnt vmcnt(0)" ::: "memory");
        }
    }
    __syncthreads();
}

DI float wave_sum(float v) {
    v += __builtin_bit_cast(float, __builtin_amdgcn_update_dpp(0, __builtin_bit_cast(int, v), 0x128, 0xF, 0xF, false));
    v += __builtin_bit_cast(float, __builtin_amdgcn_update_dpp(0, __builtin_bit_cast(int, v), 0x124, 0xF, 0xF, false));
    v += __builtin_bit_cast(float, __builtin_amdgcn_update_dpp(0, __builtin_bit_cast(int, v), 0x122, 0xF, 0xF, false));
    v += __builtin_bit_cast(float, __builtin_amdgcn_update_dpp(0, __builtin_bit_cast(int, v), 0x121, 0xF, 0xF, false));
    { auto r = __builtin_amdgcn_permlane16_swap(__float_as_uint(v), __float_as_uint(v), false, false); v = __uint_as_float(r[0]) + __uint_as_float(r[1]); }
    { auto r = __builtin_amdgcn_permlane32_swap(__float_as_uint(v), __float_as_uint(v), false, false); v = __uint_as_float(r[0]) + __uint_as_float(r[1]); }
    return v;
}
DI float wave_max(float v) {
    v = fmaxf(v, __builtin_bit_cast(float, __builtin_amdgcn_update_dpp(0, __builtin_bit_cast(int, v), 0x128, 0xF, 0xF, false)));
    v = fmaxf(v, __builtin_bit_cast(float, __builtin_amdgcn_update_dpp(0, __builtin_bit_cast(int, v), 0x124, 0xF, 0xF, false)));
    v = fmaxf(v, __builtin_bit_cast(float, __builtin_amdgcn_update_dpp(0, __builtin_bit_cast(int, v), 0x122, 0xF, 0xF, false)));
    v = fmaxf(v, __builtin_bit_cast(float, __builtin_amdgcn_update_dpp(0, __builtin_bit_cast(int, v), 0x121, 0xF, 0xF, false)));
    { auto r = __builtin_amdgcn_permlane16_swap(__float_as_uint(v), __float_as_uint(v), false, false); v = fmaxf(__uint_as_float(r[0]), __uint_as_float(r[1])); }
    { auto r = __builtin_amdgcn_permlane32_swap(__float_as_uint(v), __float_as_uint(v), false, false); v = fmaxf(__uint_as_float(r[0]), __uint_as_float(r[1])); }
    return v;
}
DI unsigned pk4i8(float a, float b, float c, float d) {
    const unsigned ua = __float_as_uint(a + 12582912.0f), ub = __float_as_uint(b + 12582912.0f), uc = __float_as_uint(c + 12582912.0f), ud = __float_as_uint(d + 12582912.0f);
    const unsigned ab = __builtin_amdgcn_perm(ub, ua, 0x0c0c0400u), cd = __builtin_amdgcn_perm(ud, uc, 0x0c0c0400u);
    return __builtin_amdgcn_perm(cd, ab, 0x05040100u);
}
DI unsigned pk2h(float lo, float hi) { f32x2 v = {lo, hi}; f16x2 h = __builtin_convertvector(v, f16x2); return __builtin_bit_cast(unsigned, h); }
typedef __bf16 bf16x2_t __attribute__((ext_vector_type(2)));
typedef __bf16 bf16x8_t __attribute__((ext_vector_type(8)));
DI unsigned pk4f8(float a, float b, float c, float d) { int w = __builtin_bit_cast(int, a); w = __builtin_amdgcn_cvt_pk_fp8_f32(a, b, w, false); w = __builtin_amdgcn_cvt_pk_fp8_f32(c, d, w, true); return (unsigned)w; }
DI unsigned pk2bf(float lo, float hi) { f32x2 v = {lo, hi}; bf16x2_t b = __builtin_convertvector(v, bf16x2_t); return __builtin_bit_cast(unsigned, b); }
DI f32x2 unpk2h(unsigned u) { f16x2 h = __builtin_bit_cast(f16x2, u); return __builtin_convertvector(h, f32x2); }
DI float sum_xor16(float x) { auto r = __builtin_amdgcn_permlane16_swap(__float_as_uint(x), __float_as_uint(x), false, false); return __uint_as_float(r[0]) + __uint_as_float(r[1]); }
DI float sum_xor32(float x) { auto r = __builtin_amdgcn_permlane32_swap(__float_as_uint(x), __float_as_uint(x), false, false); return __uint_as_float(r[0]) + __uint_as_float(r[1]); }
DI float get_xor32(float x, bool lower_half) { auto r = __builtin_amdgcn_permlane32_swap(__float_as_uint(x), __float_as_uint(x), false, false); return lower_half ? __uint_as_float(r[1]) : __uint_as_float(r[0]); }
DI float fast_rcp(float x) { return __builtin_amdgcn_rcpf(x); }
DI float fast_exp2(float x) { return __builtin_amdgcn_exp2f(x); }
DI float silu_f(float x) { return x * fast_rcp(1.0f + fast_exp2(-x * LOG2E)); }

struct Frame {
    LAS unsigned char* lds;
    int tid, lane, wave, vcu, G;
};

DI Frame phase_frame(const Frame& F0) {
    Frame F = F0; int w = F0.wave, g = F0.G, v = F0.vcu;
    asm volatile("" : "+s"(w), "+s"(g), "+s"(v));
    int ln = lane_id_opaque();
    F.wave = w; F.lane = ln; F.tid = w * 64 + ln; F.G = g; F.vcu = v;
    return F;
}

DI void glds16s(const char* sbase, unsigned voff, unsigned lds_dst) { unsigned keep;
    asm volatile("s_mov_b32 %0, m0\n\ts_mov_b32 m0, %3\n\ts_nop 0\n\tglobal_load_lds_dwordx4 %1, %2\n\ts_mov_b32 m0, %0" : "=&s"(keep) : "v"(voff), "s"(sbase), "s"(lds_dst) : "memory"); }
DI void glds4s(const char* sbase, unsigned voff, unsigned lds_dst) { unsigned keep;
    asm volatile("s_mov_b32 %0, m0\n\ts_mov_b32 m0, %3\n\ts_nop 0\n\tglobal_load_lds_dword %1, %2\n\ts_mov_b32 m0, %0" : "=&s"(keep) : "v"(voff), "s"(sbase), "s"(lds_dst) : "memory"); }
namespace pg8 {
constexpr int BM = 256, BK = 64, HALF = 128, HTB = HALF * BK * 2, STAGE_BYTES = 8 * HTB, NXCD = 8, WGM = 8;
__host__ __device__ __forceinline__ int lds_byte(int r, int c) { const int st = (r >> 4) * 2 + (c >> 5), rr = r & 15, cc = c & 31, ob = rr * 64 + cc * 2; return st * 1024 + (ob ^ (((ob >> 9) & 1) << 5)); }
__host__ __device__ __forceinline__ void stage_rc(int b, int& R, int& C) { const int st = b / 1024, sb = b % 1024, swz = sb ^ (((sb >> 9) & 1) << 5); R = (st >> 1) * 16 + swz / 64; C = (st & 1) * 32 + (swz % 64) / 2; }
__host__ __device__ __forceinline__ int perm32(int rho) { const int n = rho >> 4, i = rho & 15; return 8 * (i >> 2) + 4 * n + (i & 3); }

struct Unit { int pm, pn, ex, i0, cnt; };

DI int xcd_remap(int wgid, int nwg) { const int q = nwg / NXCD, r = nwg % NXCD, xcd = wgid % NXCD, off = wgid / NXCD; return (xcd < r ? xcd * (q + 1) : r * (q + 1) + (xcd - r) * q) + off; }

struct StaticOrder {
    static constexpr bool GATHER = false;
    int nM, nN, nwg, G, c, K;
    DI void init(int M, int N, int K_, int G_, int c_) { nM = M / BM; nN = N / BM; nwg = nM * nN; G = G_; c = c_; K = K_; }
    DI bool next(int i, Unit& u) const {
        const long L = (long)i * G + c; if (L >= nwg) return false;
        const int wgid = xcd_remap((int)L, nwg);
        const int nig = WGM * nN, gid = wgid / nig, fm = gid * WGM, gsz = (nM - fm) < WGM ? (nM - fm) : WGM;
        u.pm = fm + ((wgid % nig) % gsz); u.pn = (wgid % nig) / gsz; u.ex = 0; u.i0 = 0; u.cnt = 0; return true;
    }
    DI size_t b_off(const Unit& u) const { return (size_t)u.pn * (size_t)(BM * 2) * K; }
    DI int a_row(const Unit&, int) const { return 0; }
    DI const int* a_ptr(const Unit&, int) const { return nullptr; }
    DI int Nper_() const { return 0; }
};
template <bool GATHER_>
struct GroupOrder {
    static constexpr bool GATHER = GATHER_;
    LAS const int* tab;
    int nN, nwg, G, c, K, Nper; const int* list;
    DI void init(const unsigned* cnt, LAS int* tab_, int Nper_, int K_, int G_, int c_, const int* list_, int w) {
        if (xb_thread0(w)) { int run = 0;
            for (int e = 0; e < 8; ++e) { const int ce = (int)__hip_atomic_load((unsigned*)cnt + e * 64, __ATOMIC_RELAXED, __HIP_MEMORY_SCOPE_AGENT); tab_[e] = run; tab_[16 + e] = ce; run += (ce + 255) >> 8; }
            tab_[8] = run; }
        __syncthreads();
        tab = tab_; Nper = Nper_; nN = Nper_ / BM; nwg = __builtin_amdgcn_readfirstlane(tab_[8]) * nN; G = G_; c = c_; K = K_; list = list_;
    }
    DI bool next(int i, Unit& u) const {
        const long L = (long)i * G + c; if (L >= nwg) return false;
        const int wgid = xcd_remap((int)L, nwg);
        const int pm = wgid / nN; u.pm = pm; u.pn = wgid % nN;
        int tk[8], tc[8];
#pragma unroll
        for (int k = 0; k < 8; ++k) { tk[k] = tab[k]; tc[k] = tab[16 + k]; }
        int e = 0, base = __builtin_amdgcn_readfirstlane(tk[0]), cn = __builtin_amdgcn_readfirstlane(tc[0]);
#pragma unroll
        for (int k = 1; k < 8; ++k) { const int tkk = __builtin_amdgcn_readfirstlane(tk[k]); if (pm >= tkk) { e = k; base = tkk; cn = __builtin_amdgcn_readfirstlane(tc[k]); } }
        u.ex = e; u.i0 = (pm - base) * 256; u.cnt = cn; return true;
    }
    DI size_t b_off(const Unit& u) const { return ((size_t)u.ex * Nper + (size_t)u.pn * BM) * (size_t)K * 2; }
    DI int a_row(const Unit& u, int r) const { int idx = u.i0 + r; idx = idx < u.cnt ? idx : u.cnt - 1; return list[(size_t)u.ex * MR + idx] >> 1; }
    DI const int* a_ptr(const Unit& u, int r) const { int idx = u.i0 + r; idx = idx < u.cnt ? idx : u.cnt - 1; return list + (size_t)u.ex * MR + idx; }
    DI int Nper_() const { return Nper; }
};

struct EpiPlain {
    static constexpr bool PERM = true;
    f16* O; int ldc;
    DI void operator()(const f32x4 (&acc)[2][2][4][2], const Unit& u, int wr, int wc, int fr, int fq) const {
        const int row0 = u.pm * BM + wr * 64 + fr, col0 = u.pn * BM + wc * 32 + 8 * fq;
#pragma unroll
        for (int ai = 0; ai < 2; ++ai)
#pragma unroll
            for (int m = 0; m < 4; ++m) { f16* rowp = O + (size_t)(row0 + ai * HALF + m * 16) * ldc + col0;
#pragma unroll
                for (int bj = 0; bj < 2; ++bj) { const f32x4 v0 = acc[ai][bj][m][0], v1 = acc[ai][bj][m][1];
                    u32x4 w; w.x = pk2h(v0[0], v0[1]); w.y = pk2h(v0[2], v0[3]); w.z = pk2h(v1[0], v1[1]); w.w = pk2h(v1[2], v1[3]);
                    *(u32x4*)(rowp + bj * HALF) = w; } }
    }
};
template <bool OUT8 = false, bool ZPAD = false> struct EpiSwiglu {
    static constexpr bool PERM = true;
    f16* O; int ldc; int npn;
    DI void operator()(const f32x4 (&acc)[2][2][4][2], const Unit& u, int wr, int wc, int fr, int fq) const {
        const int row0 = u.pm * BM + wr * 64 + fr, col0 = u.pn * HALF + wc * 32 + 8 * fq;
#pragma unroll
        for (int ai = 0; ai < 2; ++ai)
#pragma unroll
            for (int m = 0; m < 4; ++m) { f16* rowp = O + (size_t)(row0 + ai * HALF + m * 16) * ldc + col0;
                const f32x4 g0 = acc[ai][0][m][0], g1 = acc[ai][0][m][1], u0 = acc[ai][1][m][0], u1 = acc[ai][1][m][1];
                if constexpr (OUT8) { u32x2 w;
#define SWC(x) __builtin_amdgcn_fmed3f((x), -448.0f, 448.0f)
                    w.x = pk4f8(SWC(silu_f(g0[0]) * u0[0]), SWC(silu_f(g0[1]) * u0[1]), SWC(silu_f(g0[2]) * u0[2]), SWC(silu_f(g0[3]) * u0[3]));
                    w.y = pk4f8(SWC(silu_f(g1[0]) * u1[0]), SWC(silu_f(g1[1]) * u1[1]), SWC(silu_f(g1[2]) * u1[2]), SWC(silu_f(g1[3]) * u1[3]));
#undef SWC
                    *(u32x2*)((unsigned char*)O + (size_t)(row0 + ai * HALF + m * 16) * ldc + col0) = w;
                    if constexpr (ZPAD) { if (u.pn == npn - 1) { unsigned z0 = 0u; asm volatile("" : "+v"(z0)); *(u32x2*)((unsigned char*)O + (size_t)(row0 + ai * HALF + m * 16) * ldc + col0 + HALF) = (u32x2){z0, z0}; } } }
                else { u32x4 w; w.x = pk2h(silu_f(g0[0]) * u0[0], silu_f(g0[1]) * u0[1]); w.y = pk2h(silu_f(g0[2]) * u0[2], silu_f(g0[3]) * u0[3]);
                w.z = pk2h(silu_f(g1[0]) * u1[0], silu_f(g1[1]) * u1[1]); w.w = pk2h(silu_f(g1[2]) * u1[2], silu_f(g1[3]) * u1[3]);
                *(u32x4*)rowp = w; } }
    }
};
struct EpiScatter {
    static constexpr bool PERM = true;
    f16* O; const int* list;
    DI void operator()(const f32x4 (&acc)[2][2][4][2], const Unit& u, int wr, int wc, int fr, int fq) const {
        const int lr0 = wr * 64 + fr, col0 = u.pn * BM + wc * 32 + 8 * fq;
        int dsts[8];
#pragma unroll
        for (int k = 0; k < 8; ++k) { int idx = u.i0 + lr0 + (k >> 2) * HALF + (k & 3) * 16; idx = idx < u.cnt ? idx : u.cnt - 1; dsts[k] = list[(size_t)u.ex * MR + idx]; }
        asm volatile("" : "+v"(dsts[0]), "+v"(dsts[1]), "+v"(dsts[2]), "+v"(dsts[3]), "+v"(dsts[4]), "+v"(dsts[5]), "+v"(dsts[6]), "+v"(dsts[7]));
#pragma unroll
        for (int ai = 0; ai < 2; ++ai)
#pragma unroll
            for (int m = 0; m < 4; ++m) { const int idx = u.i0 + lr0 + ai * HALF + m * 16;
                if (idx < u.cnt) { const int dst = dsts[ai * 4 + m]; f16* rowp = O + (size_t)dst * D + col0;
#pragma unroll
                    for (int bj = 0; bj < 2; ++bj) { const f32x4 v0 = acc[ai][bj][m][0], v1 = acc[ai][bj][m][1];
                        u32x4 w; w.x = pk2h(v0[0], v0[1]); w.y = pk2h(v0[2], v0[3]); w.z = pk2h(v1[0], v1[1]); w.w = pk2h(v1[2], v1[3]);
                        *(u32x4*)(rowp + bj * HALF) = w; } } }
    }
};

template <bool ODD> struct EpiHeads {
    static constexpr bool PERM = true;
    f16* O; int ldc; LAS const float* gl; unsigned char* V8;
    DI void operator()(f32x4 (&acc)[2][2][4][2], const Unit& u, int wr, int wc, int fr_, int fq_) const {
        const int ln = lane_id_opaque();
        const int fr = ln & 15, fq = ln >> 4;
        const int row0 = u.pm * BM + wr * 64 + fr, hc0 = u.pn * BM + 64 * wc;
        int gsel = -1; bool rope = false;
        if (ODD) { if (hc0 < 512) { gsel = 0; rope = true; } else if (hc0 < 1024) { gsel = 1; rope = true; } else if (hc0 < 1152) { gsel = 2; rope = true; } else if (hc0 >= 1280 && hc0 < 1792) { gsel = 3; rope = true; } }
        else { if (hc0 >= 1536 && hc0 < 2048) gsel = 0; else if (hc0 >= 2048 && hc0 < 2560) gsel = 1; }
        rope = rope && (u.pm < T / BM);
        const bool isv = ODD ? ((hc0 >= 1152 && hc0 < 1280) || hc0 >= 1792) : (hc0 >= 2560);
        if (gsel >= 0) {
            f32x4 gn[2][2];
#pragma unroll
            for (int bj = 0; bj < 2; ++bj)
#pragma unroll
                for (int n = 0; n < 2; ++n) gn[bj][n] = *(LAS const f32x4*)(gl + gsel * 64 + 32 * bj + 8 * fq + 4 * n);
#pragma unroll
            for (int ai = 0; ai < 2; ++ai)
#pragma unroll
                for (int m = 0; m < 4; ++m) {
                    float ss = 0.f;
#pragma unroll
                    for (int bj = 0; bj < 2; ++bj)
#pragma unroll
                        for (int n = 0; n < 2; ++n) { const f32x4 v = acc[ai][bj][m][n]; ss += (v[0] * v[0] + v[1] * v[1]) + (v[2] * v[2] + v[3] * v[3]); }
                    ss = sum_xor32(sum_xor16(ss));
                    const float rs = __builtin_amdgcn_rsqf(ss * (1.0f / 64.0f) + EPS);
#pragma unroll
                    for (int bj = 0; bj < 2; ++bj)
#pragma unroll
                        for (int n = 0; n < 2; ++n) acc[ai][bj][m][n] = acc[ai][bj][m][n] * rs * gn[bj][n];
                }
        }
        if (ODD) { if (rope) {
            const int fql = fq;
            float inv[8];
#pragma unroll
            for (int e = 0; e < 8; ++e) inv[e] = fast_exp2(-(float)(8 * (fql & 1) + e) * (13.287712379549449f / 16.0f)) * 0.15915494309189535f;
            const float sgn = fql < 2 ? -1.0f : 1.0f;
            const int rbase = row0;
#pragma unroll
            for (int ai = 0; ai < 2; ++ai) { const float pos = (float)(((rbase + ai * HALF) & (SEQ - 1)) >> 6);
                float cs[8], sn[8];
#pragma unroll
                for (int e = 0; e < 8; ++e) { const float rev = pos * inv[e]; cs[e] = __builtin_amdgcn_cosf(rev); sn[e] = __builtin_amdgcn_sinf(rev) * sgn; }
#pragma unroll
                for (int m = 0; m < 4; ++m)
#pragma unroll
                    for (int n = 0; n < 2; ++n)
#pragma unroll
                        for (int e = 0; e < 4; ++e) { const float xv = acc[ai][0][m][n][e]; const float pv = get_xor32(xv, fql < 2); acc[ai][0][m][n][e] = xv * cs[4 * n + e] + pv * sn[4 * n + e]; }
                __builtin_amdgcn_sched_barrier(0); }
#pragma unroll
            for (int m = 0; m < 4; ++m) { const float pos = (float)((rbase + m * 16) & 63);
                float cs[8], sn[8];
#pragma unroll
                for (int e = 0; e < 8; ++e) { const float rev = pos * inv[e]; cs[e] = __builtin_amdgcn_cosf(rev); sn[e] = __builtin_amdgcn_sinf(rev) * sgn; }
#pragma unroll
                for (int ai = 0; ai < 2; ++ai)
#pragma unroll
                    for (int n = 0; n < 2; ++n)
#pragma unroll
                        for (int e = 0; e < 4; ++e) { const float xv = acc[ai][1][m][n][e]; const float pv = get_xor32(xv, fql < 2); acc[ai][1][m][n][e] = xv * cs[4 * n + e] + pv * sn[4 * n + e]; }
                __builtin_amdgcn_sched_barrier(0); }
        } }
        if (ODD) { if (hc0 >= 1024 && hc0 < 1152) {
            const int kvh = (hc0 - 1024) >> 6;
#pragma unroll
            for (int ai = 0; ai < 2; ++ai) {
                unsigned char* img = V8 + WS_CK8REL + ((size_t)(kvh * (MR / 64) + u.pm * 4 + wr + 2 * ai) << 12) + (fq >> 1) * 2048 + fr * 16 + 8 * (fq & 1);
#pragma unroll
                for (int m = 0; m < 4; ++m)
#pragma unroll
                    for (int bj = 0; bj < 2; ++bj) { const f32x4 v0 = acc[ai][bj][m][0], v1 = acc[ai][bj][m][1];
                        u32x2 w; w.x = pk4f8(v0[0], v0[1], v0[2], v0[3]); w.y = pk4f8(v1[0], v1[1], v1[2], v1[3]);
                        *(u32x2*)(img + bj * 1024 + m * 256) = w; }
            }
            return;
        } else if (hc0 >= 1152 && hc0 < 1280) {
            const int kvh = (hc0 - 1152) >> 6;
#pragma unroll
            for (int ai = 0; ai < 2; ++ai) {
                unsigned char* img = V8 + WS_CV8REL + ((size_t)(kvh * (MR / 64) + u.pm * 4 + wr + 2 * ai) << 12) + ((fr >> 3) * 2 + ((fr >> 2) & 1)) * 1024 + 4 * (fr & 3) + (8 * fq) * 16;
#pragma unroll
                for (int bj = 0; bj < 2; ++bj)
#pragma unroll
                    for (int n = 0; n < 2; ++n)
#pragma unroll
                        for (int e = 0; e < 4; ++e)
                            *(unsigned*)(img + (32 * bj + 4 * n + e) * 16) = pk4f8(acc[ai][bj][0][n][e], acc[ai][bj][1][n][e], acc[ai][bj][2][n][e], acc[ai][bj][3][n][e]);
            }
            return;
        } }
        if (ODD) { if (hc0 >= 1280 && hc0 < 1792) {
            const int hh = (hc0 - 1280) >> 7, mp = ((hc0 - 1280) >> 6) & 1;
#pragma unroll
            for (int ai = 0; ai < 2; ++ai) {
                unsigned char* img = V8 + WS_K8REL + ((size_t)(hh * (MR / 64) + u.pm * 4 + wr + 2 * ai) << 13) + mp * 4096 + (fq >> 1) * 2048 + fr * 16 + 8 * (fq & 1);
#pragma unroll
                for (int m = 0; m < 4; ++m)
#pragma unroll
                    for (int bj = 0; bj < 2; ++bj) { const f32x4 v0 = acc[ai][bj][m][0], v1 = acc[ai][bj][m][1];
                        u32x2 w; w.x = pk4f8(v0[0], v0[1], v0[2], v0[3]); w.y = pk4f8(v1[0], v1[1], v1[2], v1[3]);
                        *(u32x2*)(img + bj * 1024 + m * 256) = w; }
            }
            return;
        } }
        if (ODD) { if (hc0 >= 1792) {
            const int hh = (hc0 - 1792) >> 7, cb = (hc0 - 1792) & 127;
#pragma unroll
            for (int ai = 0; ai < 2; ++ai) {
                unsigned char* img = V8 + ((size_t)(hh * (MR / 64) + u.pm * 4 + wr + 2 * ai) << 13) + ((fr >> 3) * 2 + ((fr >> 2) & 1)) * 2048 + 4 * (fr & 3) + (cb + 8 * fq) * 16;
#pragma unroll
                for (int bj = 0; bj < 2; ++bj)
#pragma unroll
                    for (int n = 0; n < 2; ++n)
#pragma unroll
                        for (int e = 0; e < 4; ++e)
                            *(unsigned*)(img + (32 * bj + 4 * n + e) * 16) = pk4f8(acc[ai][bj][0][n][e], acc[ai][bj][1][n][e], acc[ai][bj][2][n][e], acc[ai][bj][3][n][e]);
            }
            return;
        } }
#pragma unroll
        for (int ai = 0; ai < 2; ++ai)
#pragma unroll
            for (int m = 0; m < 4; ++m) { f16* rowp = O + (size_t)(row0 + ai * HALF + m * 16) * ldc + hc0 + 8 * fq;
#pragma unroll
                for (int bj = 0; bj < 2; ++bj) { const f32x4 v0 = acc[ai][bj][m][0], v1 = acc[ai][bj][m][1];
                    u32x4 w;
                    if (isv) { w.x = pk2bf(v0[0], v0[1]); w.y = pk2bf(v0[2], v0[3]); w.z = pk2bf(v1[0], v1[1]); w.w = pk2bf(v1[2], v1[3]); }
                    else { w.x = pk2h(v0[0], v0[1]); w.y = pk2h(v0[2], v0[3]); w.z = pk2h(v1[0], v1[1]); w.w = pk2h(v1[2], v1[3]); }
                    *(u32x4*)(rowp + 32 * bj) = w; } }
    }
};

struct EpiResid {
    static constexpr bool PERM = true;
    f16* H; const float* gatev;
    DI void operator()(const f32x4 (&acc)[2][2][4][2], const Unit& u, int wr, int wc, int fr, int fq) const {
        const int v = u.pm < T / BM ? (u.pm >> 5) : 4;
        const int row0 = u.pm * BM + wr * 64 + fr, col0 = u.pn * BM + wc * 32 + 8 * fq;
        const float* gv = gatev + (size_t)v * 6144 + col0;
        f32x4 g[2][2];
#pragma unroll
        for (int bj = 0; bj < 2; ++bj)
#pragma unroll
            for (int n = 0; n < 2; ++n) g[bj][n] = *(const f32x4*)(gv + bj * HALF + n * 4);
#pragma unroll
        for (int ai = 0; ai < 2; ++ai) {
            u32x4 hws[4][2];
#pragma unroll
            for (int m = 0; m < 4; ++m)
#pragma unroll
                for (int bj = 0; bj < 2; ++bj) hws[m][bj] = *(const u32x4*)(H + (size_t)(row0 + ai * HALF + m * 16) * D + col0 + bj * HALF);
#pragma unroll
            for (int m = 0; m < 4; ++m) { f16* rowp = H + (size_t)(row0 + ai * HALF + m * 16) * D + col0;
#pragma unroll
                for (int bj = 0; bj < 2; ++bj) { const u32x4 hw = hws[m][bj];
                    const f32x2 h0 = unpk2h(hw.x), h1 = unpk2h(hw.y), h2 = unpk2h(hw.z), h3 = unpk2h(hw.w);
                    const f32x4 a0 = acc[ai][bj][m][0], a1 = acc[ai][bj][m][1], g0 = g[bj][0], g1 = g[bj][1];
                    u32x4 w; w.x = pk2h(h0[0] + g0[0] * a0[0], h0[1] + g0[1] * a0[1]); w.y = pk2h(h1[0] + g0[2] * a0[2], h1[1] + g0[3] * a0[3]);
                    w.z = pk2h(h2[0] + g1[0] * a1[0], h2[1] + g1[1] * a1[1]); w.w = pk2h(h3[0] + g1[2] * a1[2], h3[1] + g1[3] * a1[3]);
                    *(u32x4*)(rowp + bj * HALF) = w; } }
            asm volatile("" ::: "memory"); }
    }
};

struct OneUnit {
    static constexpr bool GATHER = false;
    int pm, pn, K; bool on;
    DI bool next(int i, Unit& u) const { if (i != 0 || !on) return false; u.pm = pm; u.pn = pn; u.ex = 0; u.i0 = 0; u.cnt = 0; return true; }
    DI size_t b_off(const Unit& u) const { return (size_t)u.pn * (size_t)(BM * 2) * K; }
    DI int a_row(const Unit&, int) const { return 0; }
    DI const int* a_ptr(const Unit&, int) const { return nullptr; }
    DI int Nper_() const { return 0; }
};
struct EpiPairResid {
    static constexpr bool PERM = true;
    f16* H; const float* gatev; float* part; unsigned* flag; int half;
    DI void operator()(f32x4 (&acc)[2][2][4][2], const Unit& u, int wr, int wc, int fr, int fq) const {
        const int tid = (wr * 4 + wc) * 64 + fq * 16 + fr;
        f32x4* slot = (f32x4*)part + tid;
        if (half == 0) {
#pragma unroll
            for (int a = 0; a < 2; ++a)
#pragma unroll
                for (int b = 0; b < 2; ++b)
#pragma unroll
                    for (int m = 0; m < 4; ++m)
#pragma unroll
                        for (int n = 0; n < 2; ++n) slot[(((a * 2 + b) * 4 + m) * 2 + n) * 512] = acc[a][b][m][n];
            asm volatile("s_waitcnt vmcnt(0)" ::: "memory");
            __syncthreads();
            if (xb_thread0(wr * 4 + wc)) { __builtin_amdgcn_fence(__ATOMIC_RELEASE, "agent"); asm volatile("s_waitcnt vmcnt(0)" ::: "memory"); (void)xb_add(flag, 1u); }
        } else {
            if (xb_thread0(wr * 4 + wc)) { unsigned sp = 0u; while (xb_ld(flag) == 0u && ++sp < (1u << 22)) __builtin_amdgcn_s_sleep(1);
                __builtin_amdgcn_fence(__ATOMIC_ACQUIRE, "agent"); asm volatile("s_waitcnt vmcnt(0)" ::: "memory"); }
            __syncthreads();
            const int v = u.pm < T / BM ? (u.pm >> 5) : 4;
            const int row0 = u.pm * BM + wr * 64 + fr, col0 = u.pn * BM + wc * 32 + 8 * fq;
            const float* gv = gatev + (size_t)v * 6144 + col0;
            f32x4 g[2][2];
#pragma unroll
            for (int bj = 0; bj < 2; ++bj)
#pragma unroll
                for (int n = 0; n < 2; ++n) g[bj][n] = *(const f32x4*)(gv + bj * HALF + n * 4);
#pragma unroll
            for (int ai = 0; ai < 2; ++ai)
#pragma unroll
                for (int mp = 0; mp < 2; ++mp) {
                    u32x4 hws[2][2]; f32x4 ps[2][2][2];
#pragma unroll
                    for (int mm = 0; mm < 2; ++mm)
#pragma unroll
                        for (int bj = 0; bj < 2; ++bj) { const int m = 2 * mp + mm; hws[mm][bj] = *(const u32x4*)(H + (size_t)(row0 + ai * HALF + m * 16) * D + col0 + bj * HALF);
                            ps[mm][bj][0] = slot[(((ai * 2 + bj) * 4 + m) * 2 + 0) * 512]; ps[mm][bj][1] = slot[(((ai * 2 + bj) * 4 + m) * 2 + 1) * 512]; }
#pragma unroll
                    for (int mm = 0; mm < 2; ++mm) { const int m = 2 * mp + mm; f16* rowp = H + (size_t)(row0 + ai * HALF + m * 16) * D + col0;
#pragma unroll
                        for (int bj = 0; bj < 2; ++bj) { const u32x4 hw = hws[mm][bj];
                            const f32x2 h0 = unpk2h(hw.x), h1 = unpk2h(hw.y), h2 = unpk2h(hw.z), h3 = unpk2h(hw.w);
                            const f32x4 a0 = ps[mm][bj][0] + acc[ai][bj][m][0], a1 = ps[mm][bj][1] + acc[ai][bj][m][1], g0 = g[bj][0], g1 = g[bj][1];
                            u32x4 w; w.x = pk2h(h0[0] + g0[0] * a0[0], h0[1] + g0[1] * a0[1]); w.y = pk2h(h1[0] + g0[2] * a0[2], h1[1] + g0[3] * a0[3]);
                            w.z = pk2h(h2[0] + g1[0] * a1[0], h2[1] + g1[1] * a1[1]); w.w = pk2h(h3[0] + g1[2] * a1[2], h3[1] + g1[3] * a1[3]);
                            *(u32x4*)(rowp + bj * HALF) = w; } }
                    asm volatile("" ::: "memory"); }
        }
    }
};

template <class Epi, class Sched, int QM = 0>
__device__ __forceinline__ void gemm_phase(LAS unsigned char* lds, const int wave_id, const f16* Aptr, const f16* Bptr, const int K, const Sched& S, const Epi& E,
                                           const float* rs = nullptr, const float* cs = nullptr, const int ntk = 0) {
    constexpr bool F8 = (QM == 1);
    constexpr bool GATHER = Sched::GATHER;
    const int lane = lane_id_opaque();
    int wid = wave_id; asm volatile("" : "+s"(wid));
    const int tid = wid * 64 + lane, wr = wid >> 2, wc = wid & 3, fr = lane & 15, fq = lane >> 4;
    int nt = ntk ? ntk : K / BK; asm volatile("" : "+s"(nt));
    unsigned voffAc[2][2], voffAn[2][2], voffB[2]; int Rr[2], Cc[2];
#pragma unroll
    for (int i = 0; i < 2; ++i) { int R, C; stage_rc(tid * 16 + i * 8192, R, C); const int Rb = Epi::PERM ? ((R & ~31) + perm32(R & 31)) : R; Rr[i] = R; Cc[i] = C;
        voffB[i] = (unsigned)(Rb * K + C) * 2u;
#pragma unroll
        for (int h = 0; h < 2; ++h) { voffAc[h][i] = (unsigned)((R + HALF * h) * K + C) * 2u; voffAn[h][i] = voffAc[h][i]; } }
    const size_t kstep = (size_t)(BK * 2);
    const size_t q64 = (size_t)64 * K * 2;
    const size_t hstep = (size_t)HALF * K * 2;
    const size_t tstep = 2 * hstep;
    const unsigned ldsw = (unsigned)wid * 1024u;
    const unsigned ldsa = (unsigned)(unsigned long)lds + ldsw;
    const int aoff = lds_byte(wr * 64 + fr, fq * 8), boff = lds_byte(wc * 32 + fr, fq * 8);
#define PG8_SA(b, h) (((b) * 2 + (h)) * HTB)
#define PG8_SB(b, h) ((4 + (b) * 2 + (h)) * HTB)
#define PG8_STAGE_B(bufoff, gbase) do { _Pragma("unroll") for (int _i = 0; _i < 2; ++_i) \
        glds16s((const char*)(gbase) + (size_t)_i * q64, voffB[0], ldsa + (unsigned)((bufoff) + _i * 8192)); } while (0)
#define PG8_STAGE_A(bufoff, gbase, h, NX) do { _Pragma("unroll") for (int _i = 0; _i < 2; ++_i) { \
        if constexpr (GATHER) { const unsigned _vo = (NX) ? voffAn[h][_i] : voffAc[h][_i]; glds16s((const char*)(gbase), _vo, ldsa + (unsigned)((bufoff) + _i * 8192)); } \
        else glds16s((const char*)(gbase) + (size_t)(2 * (h) + _i) * q64, voffAc[0][0], ldsa + (unsigned)((bufoff) + _i * 8192)); } } while (0)
#define PG8_LDA(dst, b, h) do { _Pragma("unroll") for (int m = 0; m < 4; ++m) _Pragma("unroll") for (int k = 0; k < 2; ++k) dst[m][k] = *(const LAS f16x8*)(lds + PG8_SA(b, h) + aoff + m * 2048 + k * 1024); } while (0)
#define PG8_LDB(dst, b, h) do { _Pragma("unroll") for (int n = 0; n < 2; ++n) _Pragma("unroll") for (int k = 0; k < 2; ++k) dst[n][k] = *(const LAS f16x8*)(lds + PG8_SB(b, h) + boff + n * 2048 + k * 1024); } while (0)
#define PG8_MMA(ai, bj, At, Bt) do { __builtin_amdgcn_s_setprio(1); \
        if constexpr (F8) { _Pragma("unroll") for (int m = 0; m < 4; ++m) _Pragma("unroll") for (int n = 0; n < 2; ++n) \
            acc[ai][bj][m][n] = __builtin_amdgcn_mfma_scale_f32_16x16x128_f8f6f4(__builtin_bit_cast(i32x8, __builtin_shufflevector(Bt[n][0], Bt[n][1], 0, 1, 2, 3, 4, 5, 6, 7, 8, 9, 10, 11, 12, 13, 14, 15)), \
                __builtin_bit_cast(i32x8, __builtin_shufflevector(At[m][0], At[m][1], 0, 1, 2, 3, 4, 5, 6, 7, 8, 9, 10, 11, 12, 13, 14, 15)), acc[ai][bj][m][n], 0, 0, 0, 0, 0, 0); } \
        else if constexpr (QM == 2) { _Pragma("unroll") for (int m = 0; m < 4; ++m) _Pragma("unroll") for (int n = 0; n < 2; ++n) _Pragma("unroll") for (int k = 0; k < 2; ++k) \
            acc[ai][bj][m][n] = __builtin_bit_cast(f32x4, __builtin_amdgcn_mfma_i32_16x16x64_i8(__builtin_bit_cast(i32x4, Bt[n][k]), __builtin_bit_cast(i32x4, At[m][k]), __builtin_bit_cast(i32x4, acc[ai][bj][m][n]), 0, 0, 0)); } \
        else { _Pragma("unroll") for (int m = 0; m < 4; ++m) _Pragma("unroll") for (int n = 0; n < 2; ++n) _Pragma("unroll") for (int k = 0; k < 2; ++k) \
            acc[ai][bj][m][n] = __builtin_amdgcn_mfma_f32_16x16x32_f16(Bt[n][k], At[m][k], acc[ai][bj][m][n], 0, 0, 0); } __builtin_amdgcn_s_setprio(0); } while (0)
#define PG8_WAIT_V(n) asm volatile("s_waitcnt vmcnt(" #n ")" ::: "memory")
#define PG8_WAIT_L(n) asm volatile("s_waitcnt lgkmcnt(" #n ")" ::: "memory")
#define PG8_BAR __builtin_amdgcn_s_barrier()
#define PG8_SCHED __builtin_amdgcn_sched_barrier(0)
    Unit cur, nxt; int ui = 0;
    if (!S.next(0, cur)) return;
    if constexpr (GATHER) {
#pragma unroll
        for (int h = 0; h < 2; ++h)
#pragma unroll
            for (int i = 0; i < 2; ++i) voffAc[h][i] = (unsigned)(S.a_row(cur, HALF * h + Rr[i]) * K + Cc[i]) * 2u;
    }
    f32x4 acc[2][2][4][2];
#pragma unroll
    for (int a = 0; a < 2; ++a)
#pragma unroll
        for (int b = 0; b < 2; ++b)
#pragma unroll
            for (int m = 0; m < 4; ++m)
#pragma unroll
                for (int n = 0; n < 2; ++n) acc[a][b][m][n] = (f32x4){0.f, 0.f, 0.f, 0.f};
    f16x8 At[4][2], B0[2][2], B1[2][2];
    const char* cA = (const char*)Aptr + (GATHER ? (size_t)0 : (size_t)cur.pm * tstep); const char* cB = (const char*)Bptr + S.b_off(cur);
    PG8_STAGE_B(PG8_SB(0, 0), cB); PG8_STAGE_B(PG8_SB(0, 1), cB + hstep); PG8_STAGE_A(PG8_SA(0, 0), cA, 0, false); PG8_STAGE_A(PG8_SA(0, 1), cA, 1, false);
    if (wr == 1) PG8_BAR;
    PG8_WAIT_V(2); PG8_BAR;
    PG8_STAGE_B(PG8_SB(1, 0), cB + kstep); PG8_STAGE_A(PG8_SA(1, 0), cA + kstep, 0, false); PG8_STAGE_B(PG8_SB(1, 1), cB + hstep + kstep);
    PG8_WAIT_V(6); PG8_BAR;
    for (;;) {
        const bool has_next = S.next(ui + 1, nxt);
        const char* nA = (has_next && !GATHER) ? (const char*)Aptr + (size_t)nxt.pm * tstep : cA; const char* nB = has_next ? (const char*)Bptr + S.b_off(nxt) : cB;
        unsigned lraw[2][2] = {{0u, 0u}, {0u, 0u}};
        if constexpr (GATHER) {
            if (has_next) {
#pragma unroll
                for (int h = 0; h < 2; ++h)
#pragma unroll
                    for (int i = 0; i < 2; ++i) { const int* lp = S.a_ptr(nxt, HALF * h + Rr[i]); asm volatile("global_load_dword %0, %1, off" : "=v"(lraw[h][i]) : "v"(lp) : "memory"); }
            }
#pragma unroll
            for (int h = 0; h < 2; ++h)
#pragma unroll
                for (int i = 0; i < 2; ++i) voffAn[h][i] = voffAc[h][i];
        }
        unsigned ltk[4] = {0u, 0u, 0u, 0u};
        for (int t = 0; t < nt; t += 2) {
            const bool last = (t == nt - 2);
            if constexpr (QM == 2) {
                if constexpr (GATHER) {
                    if (t == nt - 4 && wid == 0) {
#pragma unroll
                        for (int j = 0; j < 4; ++j) { const int* lp = S.a_ptr(cur, 64 * j + lane); asm volatile("global_load_dword %0, %1, off" : "=v"(ltk[j]) : "v"(lp) : "memory"); } }
                    if (last && wid == 0) {
#pragma unroll
                        for (int j = 0; j < 4; ++j) { unsigned lv = ltk[j]; asm volatile("" : "+v"(lv)); glds4s((const char*)rs, (lv >> 1) * 4u, (unsigned)(unsigned long)lds + (unsigned)(LDSCTL_OFF + 2048 + 256 * j)); } }
                    if (last && wid == 1) glds16s((const char*)(cs + (size_t)cur.ex * S.Nper_() + cur.pn * BM), (unsigned)lane * 16u, (unsigned)(unsigned long)lds + (unsigned)(LDSCTL_OFF + 3072));
                } else
                if (last && wid < 2) { const char* sb = (wid == 0) ? (const char*)(rs + cur.pm * BM) : (const char*)(cs + (size_t)cur.ex * S.Nper_() + cur.pn * BM);
                    glds16s(sb, (unsigned)lane * 16u, (unsigned)(unsigned long)lds + (unsigned)(LDSCTL_OFF + 2048) + (unsigned)wid * 1024u); }
            }
            if constexpr (GATHER) {
                if (t == 2 && has_next) {
#pragma unroll
                    for (int h = 0; h < 2; ++h)
#pragma unroll
                        for (int i = 0; i < 2; ++i) { unsigned lv = lraw[h][i]; asm volatile("" : "+v"(lv)); voffAn[h][i] = (unsigned)((int)(lv >> 1) * K + Cc[i]) * 2u; }
                }
            }
            const char* a1 = cA + (size_t)(t + 1) * kstep;
            const char* a2 = last ? nA : cA + (size_t)(t + 2) * kstep; const char* b2 = last ? nB : cB + (size_t)(t + 2) * kstep;
            const char* a3 = a2 + kstep; const char* b3 = b2 + kstep;
            PG8_LDB(B0, 0, 0); PG8_LDB(B1, 0, 1); PG8_SCHED; PG8_LDA(At, 0, 0); PG8_STAGE_A(PG8_SA(1, 1), a1, 1, false);
            PG8_WAIT_V(8); PG8_WAIT_L(0); PG8_BAR; PG8_MMA(0, 0, At, B0); PG8_MMA(0, 1, At, B1); PG8_BAR; PG8_SCHED;
            PG8_LDA(At, 0, 1); PG8_STAGE_B(PG8_SB(0, 0), b2); PG8_STAGE_B(PG8_SB(0, 1), b2 + hstep); PG8_STAGE_A(PG8_SA(0, 0), a2, 0, last);
            PG8_WAIT_V(8); PG8_WAIT_L(0); PG8_BAR; PG8_MMA(1, 0, At, B0); PG8_MMA(1, 1, At, B1); PG8_BAR; PG8_SCHED;
            PG8_LDB(B0, 1, 0); PG8_LDB(B1, 1, 1); PG8_SCHED; PG8_LDA(At, 1, 0); PG8_STAGE_A(PG8_SA(0, 1), a2, 1, last);
            PG8_WAIT_V(8); PG8_WAIT_L(0); PG8_BAR; PG8_MMA(0, 0, At, B0); PG8_MMA(0, 1, At, B1); PG8_BAR; PG8_SCHED;
            PG8_LDA(At, 1, 1); PG8_STAGE_B(PG8_SB(1, 0), b3); PG8_STAGE_B(PG8_SB(1, 1), b3 + hstep); PG8_STAGE_A(PG8_SA(1, 0), a3, 0, last);
            PG8_WAIT_V(8); PG8_WAIT_L(0); PG8_BAR; PG8_MMA(1, 0, At, B0); PG8_MMA(1, 1, At, B1); PG8_BAR; PG8_SCHED;
        }
        if (wr == 0) PG8_BAR;
        if constexpr (F8) {
#pragma unroll
            for (int a = 0; a < 2; ++a)
#pragma unroll
                for (int b = 0; b < 2; ++b)
#pragma unroll
                    for (int m = 0; m < 4; ++m)
#pragma unroll
                        for (int n = 0; n < 2; ++n) acc[a][b][m][n] = acc[a][b][m][n] * (1.0f / W8S);
        }
        if constexpr (QM == 2) {
            LAS const float* sr = (LAS const float*)(lds + LDSCTL_OFF + 2048) + wr * 64 + fr;
            LAS const float* sc = (LAS const float*)(lds + LDSCTL_OFF + 3072) + wc * 32 + 8 * fq;
            f32x4 c4[4]; float r8[8];
#pragma unroll
            for (int b = 0; b < 2; ++b)
#pragma unroll
                for (int n = 0; n < 2; ++n) c4[b * 2 + n] = *(LAS const f32x4*)(sc + b * HALF + n * 4);
#pragma unroll
            for (int a = 0; a < 2; ++a)
#pragma unroll
                for (int m = 0; m < 4; ++m) r8[a * 4 + m] = sr[a * HALF + m * 16];
            asm volatile("s_waitcnt lgkmcnt(0)" ::: "memory");
#pragma unroll
            for (int a = 0; a < 2; ++a)
#pragma unroll
                for (int m = 0; m < 4; ++m) { const float r = r8[a * 4 + m];
#pragma unroll
                    for (int b = 0; b < 2; ++b)
#pragma unroll
                        for (int n = 0; n < 2; ++n) { const f32x4 c = c4[b * 2 + n]; const i32x4 iv = __builtin_bit_cast(i32x4, acc[a][b][m][n]);
                            acc[a][b][m][n] = (f32x4){(float)iv[0] * (r * c[0]), (float)iv[1] * (r * c[1]), (float)iv[2] * (r * c[2]), (float)iv[3] * (r * c[3])}; } }
        }
        E(acc, cur, wr, wc, fr, fq);
        if (!has_next) break;
#pragma unroll
        for (int a = 0; a < 2; ++a)
#pragma unroll
            for (int b = 0; b < 2; ++b)
#pragma unroll
                for (int m = 0; m < 4; ++m)
#pragma unroll
                    for (int n = 0; n < 2; ++n) acc[a][b][m][n] = (f32x4){0.f, 0.f, 0.f, 0.f};
        cur = nxt; cA = nA; cB = nB; ++ui;
        if constexpr (GATHER) {
#pragma unroll
            for (int h = 0; h < 2; ++h)
#pragma unroll
                for (int i = 0; i < 2; ++i) voffAc[h][i] = voffAn[h][i];
        }
        if (wr == 1) PG8_BAR;
    }
    PG8_WAIT_V(0);
    PG8_BAR;
#undef PG8_SA
#undef PG8_SB
#undef PG8_STAGE_A
#undef PG8_STAGE_B
#undef PG8_LDA
#undef PG8_LDB
#undef PG8_MMA
#undef PG8_WAIT_V
#undef PG8_WAIT_L
#undef PG8_BAR
#undef PG8_SCHED
}
}

struct Args {
    const float* x; const float* c; const float* ctx; const float* c_ctx; const float* ada_w; const float* ada_b; const float* norm1_g; const float* norm2_g;
    const float* ev_w_in; const float* ev_conv_w; const float* ev_q_g; const float* ev_k_g; const float* ev_rpb; const float* ev_w_out;
    const float* ffn_w1; const float* ffn_w3; const float* ffn_w2;
    const float* od_w_in; const float* od_cq_g; const float* od_ck_g; const float* od_sink; const float* od_dq_g; const float* od_dk_g;
    const float* od_lam_q1; const float* od_lam_k1; const float* od_lam_q2; const float* od_lam_k2; const float* od_subln_g; const float* od_w_out;
    const float* moe_router; const float* moe_w1; const float* moe_w3; const float* moe_w2;
    float* out; unsigned char* ws;
};

template <bool F8>
DI void p0_transpose_item(const float* W, int K, int N, unsigned char* WT, int map, LAS float* scr, int item, int lane, int pitch) {
    const int nblk = N / 32, kb = item / nblk, nb = item % nblk, k0 = 64 * kb, n0 = 32 * nb;
    const int d0 = (map == 0) ? n0 : (map == 3) ? ((n0 >> 8) * 256 + ((n0 >> 5) & 1) * 128 + ((n0 >> 6) & 3) * 32) : ((n0 >> 7) * 256 + (map - 1) * 128 + (n0 & 127));
    float tv[32];
#pragma unroll
    for (int i = 0; i < 32; ++i) tv[i] = __builtin_nontemporal_load(W + (size_t)(k0 + 2 * i + (lane >> 5)) * N + n0 + (lane & 31));
#pragma unroll
    for (int i = 0; i < 32; ++i) scr[(2 * i + (lane >> 5)) * 33 + (lane & 31)] = tv[i];
    asm volatile("s_waitcnt lgkmcnt(0)" ::: "memory");
    const int c = lane & 7;
#pragma unroll
    for (int j = 0; j < 4; ++j) { const int n = (lane >> 3) + 8 * j; const LAS float* s = scr + (8 * c) * 33 + n;
        if constexpr (F8) { u32x2 o; o.x = pk4f8(s[0 * 33] * W8S, s[1 * 33] * W8S, s[2 * 33] * W8S, s[3 * 33] * W8S); o.y = pk4f8(s[4 * 33] * W8S, s[5 * 33] * W8S, s[6 * 33] * W8S, s[7 * 33] * W8S); *(u32x2*)(WT + (size_t)(d0 + n) * pitch + k0 + 8 * c) = o; }
        else { u32x4 o; o.x = pk2h(s[0 * 33], s[1 * 33]); o.y = pk2h(s[2 * 33], s[3 * 33]); o.z = pk2h(s[4 * 33], s[5 * 33]); o.w = pk2h(s[6 * 33], s[7 * 33]);
            *(u32x4*)((f16*)WT + (size_t)(d0 + n) * pitch + k0 + 8 * c) = o; } }
    asm volatile("s_waitcnt lgkmcnt(0)" ::: "memory");
}
template <bool F8 = false>
DI void p0_convert(Frame& F, const float* W, int nmat, int K, int N, unsigned char* dst, size_t dst_stride, int map, LAS float* scr, int pitch = 0) {
    if (pitch == 0) pitch = K;
    const int gw = F.vcu * NWAVES + F.wave, NGW = F.G * NWAVES;
    const int ipm = (K / 64) * (N / 32), total = ipm * nmat;
    for (int it = gw; it < total; it += NGW) { const int m = it / ipm, r = it - m * ipm;
        p0_transpose_item<F8>(W + (size_t)m * K * N, K, N, dst + (size_t)m * dst_stride, map, scr, r, F.lane, pitch); }
}
DI void p0_convert_i8(Frame& F, const float* W, int nmat, int N, unsigned char* dst, size_t dst_stride, float* cs, int cs_stride, int map) {
    constexpr int K = 1024;
    LAS float* red = (LAS float*)F.lds;
    const int lane = F.lane, n = lane & 31, hf = lane >> 5, strips = N / 32;
    for (int it = F.vcu; it < nmat * strips; it += F.G) {
        const int mt = it / strips, n0 = (it - mt * strips) * 32;
        const float* Wp = W + (size_t)mt * K * N + (size_t)(128 * F.wave + 64 * hf) * N + n0 + n;
        const int d0 = (map == 0) ? n0 : (map == 3) ? ((n0 >> 8) * 256 + ((n0 >> 5) & 1) * 128 + ((n0 >> 6) & 3) * 32) : ((n0 >> 7) * 256 + (map - 1) * 128 + (n0 & 127));
        float v[64]; float mx = 0.f;
#pragma unroll
        for (int i = 0; i < 64; ++i) { v[i] = __builtin_nontemporal_load(Wp + (size_t)i * N); mx = fmaxf(mx, fabsf(v[i])); }
        { auto r = __builtin_amdgcn_permlane32_swap(__float_as_uint(mx), __float_as_uint(mx), false, false); mx = fmaxf(__uint_as_float(r[0]), __uint_as_float(r[1])); }
        if (hf == 0) red[F.wave * 32 + n] = mx;
        __syncthreads();
        float cm = 0.f;
#pragma unroll
        for (int w = 0; w < 8; ++w) cm = fmaxf(cm, red[w * 32 + n]);
        cm = fmaxf(cm, 1e-30f);
        const float inv = 127.0f / cm;
        if (F.wave == 0 && hf == 0) cs[(size_t)mt * cs_stride + d0 + n] = cm * (1.0f / 127.0f);
        unsigned char* op = dst + (size_t)mt * dst_stride + (size_t)(d0 + n) * K + 128 * F.wave + 64 * hf;
#pragma unroll
        for (int j = 0; j < 4; ++j) { u32x4 o;
            o.x = pk4i8(v[16 * j + 0] * inv, v[16 * j + 1] * inv, v[16 * j + 2] * inv, v[16 * j + 3] * inv);
            o.y = pk4i8(v[16 * j + 4] * inv, v[16 * j + 5] * inv, v[16 * j + 6] * inv, v[16 * j + 7] * inv);
            o.z = pk4i8(v[16 * j + 8] * inv, v[16 * j + 9] * inv, v[16 * j + 10] * inv, v[16 * j + 11] * inv);
            o.w = pk4i8(v[16 * j + 12] * inv, v[16 * j + 13] * inv, v[16 * j + 14] * inv, v[16 * j + 15] * inv);
            *(u32x4*)(op + 16 * j) = o; }
        __syncthreads();
    }
}
DI void moe_convert(const Frame& F0, const float* w1, const float* w3, const float* w2, unsigned char* wsb, int i, int parts) {
    Frame F = phase_frame(F0);
    LAS float* scr = (LAS float*)(F.lds + F.wave * 8448);
    if constexpr (Q_G3G == 2) { if (parts & 1) p0_convert_i8(F, w1 + (size_t)i * NE * D * DFE, NE, DFE, wsb + WS_MOE + MOE_13, (size_t)2 * DFE * D, (float*)(wsb + WS_CS_MOE), 2 * DFE, 1);
                                if (parts & 2) p0_convert_i8(F, w3 + (size_t)i * NE * D * DFE, NE, DFE, wsb + WS_MOE + MOE_13, (size_t)2 * DFE * D, (float*)(wsb + WS_CS_MOE), 2 * DFE, 2); }
    else { if (parts & 1) p0_convert(F, w1 + (size_t)i * NE * D * DFE, NE, D, DFE, wsb + WS_MOE + MOE_13, (size_t)2 * DFE * D * 2, 1, scr);
           if (parts & 2) p0_convert(F, w3 + (size_t)i * NE * D * DFE, NE, D, DFE, wsb + WS_MOE + MOE_13, (size_t)2 * DFE * D * 2, 2, scr); }
    if (!(parts & 4)) return;
    if constexpr (F8_G4G) { p0_convert<true>(F, w2 + (size_t)i * NE * DFE * D, NE, DFE, D, wsb + WS_MOE + MOE_2, (size_t)D * DFEP, 0, scr, DFEP);
        unsigned z0 = 0u; asm volatile("" : "+v"(z0));
        for (int j = (F.vcu * NTHREADS + F.tid); j < NE * D * 8; j += F.G * NTHREADS) *(u32x4*)(wsb + WS_MOE + MOE_2 + (size_t)(j >> 3) * DFEP + DFE + 16 * (j & 7)) = (u32x4){z0, z0, z0, z0}; }
    else p0_convert(F, w2 + (size_t)i * NE * DFE * D, NE, DFE, D, wsb + WS_MOE + MOE_2, (size_t)D * DFE * 2, 0, scr);
}
DI void conv_even_layer(const Frame& F0, const float* w_in, const float* w_out, const float* f1, const float* f3, const float* f2, unsigned char* wsb, int i, int parts = 3) {
    Frame F = phase_frame(F0);
    LAS float* scr = (LAS float*)(F.lds + F.wave * 8448);
    unsigned char* wl = wsb + WS_WEV + (size_t)i * EVW_SZ;
    if (parts & 1) {
    if constexpr (Q_G1E == 2) p0_convert_i8(F, w_in + (size_t)i * D * EVN, 1, EVN, wl + EVW_IN, EVW_SZ, (float*)(wsb + WS_CS_EVIN) + (size_t)i * EVN, EVN, 3);
    else p0_convert(F, w_in + (size_t)i * D * EVN, 1, D, EVN, wl + EVW_IN, EVW_SZ, 3, scr);
    p0_convert(F, w_out + (size_t)i * D * D, 1, D, D, wl + EVW_OUT, EVW_SZ, 0, scr); }
    if (!(parts & 2)) return;
    if constexpr (Q_G3E == 2) { p0_convert_i8(F, f1 + (size_t)i * D * DFF, 1, DFF, wl + EVW_13, EVW_SZ, (float*)(wsb + WS_CS_F13) + (size_t)i * 2 * DFF, 2 * DFF, 1);
                                p0_convert_i8(F, f3 + (size_t)i * D * DFF, 1, DFF, wl + EVW_13, EVW_SZ, (float*)(wsb + WS_CS_F13) + (size_t)i * 2 * DFF, 2 * DFF, 2); }
    else { p0_convert(F, f1 + (size_t)i * D * DFF, 1, D, DFF, wl + EVW_13, EVW_SZ, 1, scr); p0_convert(F, f3 + (size_t)i * D * DFF, 1, D, DFF, wl + EVW_13, EVW_SZ, 2, scr); }
    p0_convert<F8_G4>(F, f2 + (size_t)i * DFF * D, 1, DFF, D, wl + EVW_2, EVW_SZ, 0, scr);
}
DI void conv_odd_layer(const Frame& F0, const float* w_in, const float* w_out, unsigned char* wsb, int i) {
    Frame F = phase_frame(F0);
    LAS float* scr = (LAS float*)(F.lds + F.wave * 8448);
    unsigned char* wl = wsb + WS_WOD + (size_t)i * ODS_SZ;
    if constexpr (Q_G1O == 2) p0_convert_i8(F, w_in + (size_t)i * D * ODN, 1, ODN, wl + ODW_IN, ODS_SZ, (float*)(wsb + WS_CS_ODIN) + (size_t)i * ODN, ODN, 3);
    else p0_convert(F, w_in + (size_t)i * D * ODN, 1, D, ODN, wl + ODW_IN, ODS_SZ, 3, scr);
    p0_convert(F, w_out + (size_t)i * D * D, 1, D, D, wl + ODW_OUT, ODS_SZ, 0, scr);
}
DI void p0_prologue(const Frame& F0, const __attribute__((address_space(4))) Args* ap) {
    Frame F = phase_frame(F0);
    struct { const float *c, *c_ctx, *ada_w, *ada_b, *ev_w_in, *ev_w_out, *ffn_w1, *ffn_w3, *ffn_w2, *od_w_in, *od_w_out; unsigned char* ws; } a;
    a.c = ap->c; a.c_ctx = ap->c_ctx; a.ada_w = ap->ada_w; a.ada_b = ap->ada_b; a.ev_w_in = ap->ev_w_in; a.ev_w_out = ap->ev_w_out; a.ffn_w1 = ap->ffn_w1; a.ffn_w3 = ap->ffn_w3; a.ffn_w2 = ap->ffn_w2;
    a.od_w_in = ap->od_w_in; a.od_w_out = ap->od_w_out; a.ws = ap->ws;
    LAS float* scr = (LAS float*)(F.lds + F.wave * 8448);
    LAS float* sv = (LAS float*)(F.lds + 8 * 8448);
    LAS float* red = (LAS float*)(F.lds + 8 * 8448 + 20480);
    for (int i = F.tid; i < 5 * 1024; i += NTHREADS) { const float v = (i < 4096) ? a.c[i] : a.c_ctx[i - 4096]; sv[i] = silu_f(v); }
    __syncthreads();
    float* mod = (float*)(a.ws + WS_MOD);
    for (int it = F.vcu; it < 4 * 96; it += F.G) {
        const int l = it / 96, n = (it % 96) * 64 + F.lane, k0 = 128 * F.wave;
        const float* wp = a.ada_w + (size_t)l * 1024 * 6144 + (size_t)k0 * 6144 + n;
        float a0 = 0.f, a1 = 0.f, a2 = 0.f, a3 = 0.f, a4 = 0.f;
#pragma unroll 32
        for (int k = 0; k < 128; ++k) { const float w = __builtin_nontemporal_load(wp + (size_t)k * 6144);
            a0 += sv[k0 + k] * w; a1 += sv[1024 + k0 + k] * w; a2 += sv[2048 + k0 + k] * w; a3 += sv[3072 + k0 + k] * w; a4 += sv[4096 + k0 + k] * w; }
        LAS float* rw = red + F.wave * 320 + F.lane;
        rw[0] = a0; rw[64] = a1; rw[128] = a2; rw[192] = a3; rw[256] = a4;
        __syncthreads();
        if (F.wave < 5) { float sum = 0.f;
#pragma unroll
            for (int w = 0; w < 8; ++w) sum += red[w * 320 + F.wave * 64 + F.lane];
            mod[(size_t)l * 5 * 6144 + (size_t)F.wave * 6144 + n] = sum + a.ada_b[l * 6144 + n]; }
        __syncthreads();
    }
    { Frame Fc = F; Fc.vcu = (F.vcu + F.G / 2) % F.G;
      conv_even_layer(Fc, a.ev_w_in, a.ev_w_out, a.ffn_w1, a.ffn_w3, a.ffn_w2, a.ws, 0, 1); }
}

struct RowPassP {
    const float* xin_lat; const float* xin_ctx;
    f16* H;
    float* out32;
    const f16* ysrc; const float* gatew; const float* modg;
    int gate_chunk;
    const float* modn; int sc_chunk, sh_chunk; const float* normg;
    f16* Aout;
    const float* router; int* list; unsigned* cnt; float* gateout;
    int nrows;
    float* rscale;
};
template <int RES, bool NORM, bool ROUTE, bool STORE_H, bool IN32 = false, bool OUT32 = false, int A8 = 0>
DI void row_pass(const Frame& F0, const RowPassP& p) {
    Frame F = phase_frame(F0);
    LAS float* rt = (LAS float*)F.lds;
    LAS unsigned char* selb = F.lds + 32768;
    const int rpb_ = (p.nrows + F.G - 1) / F.G;
    const int rb0 = F.vcu * rpb_;
    const int lane = F.lane;
    f32x4 rw[16][2];
    if constexpr (ROUTE) {
#pragma unroll
        for (int c = 0; c < 16; ++c) { const float* rp = p.router + (size_t)(4 * lane + 256 * (c >> 2) + (c & 3)) * 8; rw[c][0] = *(const f32x4*)rp; rw[c][1] = *(const f32x4*)(rp + 4); }
#pragma unroll
        for (int c = 0; c < 16; c += 4) asm volatile("" : "+v"(rw[c][0]), "+v"(rw[c][1]), "+v"(rw[c + 1][0]), "+v"(rw[c + 1][1]), "+v"(rw[c + 2][0]), "+v"(rw[c + 2][1]), "+v"(rw[c + 3][0]), "+v"(rw[c + 3][1]));
    }
    int vc = -1; f32x4 gsc[4], shc[4], ggc[4];
    for (int lr = F.wave; lr < rpb_; lr += NWAVES) {
        const int row = rb0 + lr; if (row >= p.nrows) break;
        const int v = row < T ? (row >> 13) : 4;
        if (v != vc) { vc = v;
            if constexpr (NORM) { const float* scv = p.modn + (size_t)v * 6144 + p.sc_chunk * 1024; const float* shv = p.modn + (size_t)v * 6144 + p.sh_chunk * 1024;
#pragma unroll
                for (int j = 0; j < 4; ++j) { const f32x4 g = *(const f32x4*)(p.normg + 4 * lane + 256 * j); const f32x4 sc = *(const f32x4*)(scv + 4 * lane + 256 * j); gsc[j] = g * (sc + 1.0f); shc[j] = *(const f32x4*)(shv + 4 * lane + 256 * j); } }
            if constexpr (RES == 2) { const float* gv = p.modg + (size_t)v * 6144 + p.gate_chunk * 1024;
#pragma unroll
                for (int j = 0; j < 4; ++j) ggc[j] = *(const f32x4*)(gv + 4 * lane + 256 * j); }
        }
        f32x4 xv[4];
        if constexpr (IN32) { const float* hrow = row < T ? p.xin_lat + (size_t)row * D : p.xin_ctx + (size_t)(row - T) * D;
#pragma unroll
            for (int j = 0; j < 4; ++j) xv[j] = __builtin_nontemporal_load((const f32x4*)(hrow + 4 * lane + 256 * j));
        } else {
#pragma unroll
            for (int j = 0; j < 4; ++j) { const u32x2 hh = OUT32 ? __builtin_nontemporal_load((const u32x2*)(p.H + (size_t)row * D + 4 * lane + 256 * j)) : *(const u32x2*)(p.H + (size_t)row * D + 4 * lane + 256 * j); const f32x2 a = unpk2h(hh.x), b = unpk2h(hh.y); xv[j] = (f32x4){a[0], a[1], b[0], b[1]}; }
        }
        if constexpr (RES == 2) {
            const float wa = p.gatew[2 * row], wb = p.gatew[2 * row + 1];
#pragma unroll
            for (int j = 0; j < 4; ++j) { const u32x2 ya = __builtin_nontemporal_load((const u32x2*)(p.ysrc + (size_t)(2 * row) * D + 4 * lane + 256 * j)); const u32x2 yb = __builtin_nontemporal_load((const u32x2*)(p.ysrc + (size_t)(2 * row + 1) * D + 4 * lane + 256 * j));
                const f32x2 a0 = unpk2h(ya.x), a1 = unpk2h(ya.y), b0 = unpk2h(yb.x), b1 = unpk2h(yb.y);
                const f32x4 g = ggc[j];
                xv[j][0] += g[0] * (wa * a0[0] + wb * b0[0]); xv[j][1] += g[1] * (wa * a0[1] + wb * b0[1]); xv[j][2] += g[2] * (wa * a1[0] + wb * b1[0]); xv[j][3] += g[3] * (wa * a1[1] + wb * b1[1]); }
        }
        if constexpr (STORE_H) {
#pragma unroll
            for (int j = 0; j < 4; ++j) { u32x2 w; w.x = pk2h(xv[j][0], xv[j][1]); w.y = pk2h(xv[j][2], xv[j][3]); *(u32x2*)(p.H + (size_t)row * D + 4 * lane + 256 * j) = w; }
        }
        if constexpr (OUT32) {
#pragma unroll
            for (int j = 0; j < 4; ++j) __builtin_nontemporal_store(xv[j], (f32x4*)(p.out32 + (size_t)row * D + 4 * lane + 256 * j));
        }
        if constexpr (NORM) {
            float ss = 0.f;
#pragma unroll
            for (int j = 0; j < 4; ++j) ss += (xv[j][0] * xv[j][0] + xv[j][1] * xv[j][1]) + (xv[j][2] * xv[j][2] + xv[j][3] * xv[j][3]);
            const float rstd = __builtin_amdgcn_rsqf(wave_sum(ss) * (1.0f / D) + EPS);
            f32x4 av[4];
            if constexpr (A8 == 2) {
                float am = 0.f;
#pragma unroll
                for (int j = 0; j < 4; ++j) { av[j] = (xv[j] * rstd) * gsc[j] + shc[j]; am = fmaxf(am, fmaxf(fmaxf(fabsf(av[j][0]), fabsf(av[j][1])), fmaxf(fabsf(av[j][2]), fabsf(av[j][3])))); }
                am = fmaxf(wave_max(am), 1e-30f);
                const float inv = 127.0f / am;
                if (lane == 0) p.rscale[row] = am * (1.0f / 127.0f);
#pragma unroll
                for (int j = 0; j < 4; ++j) *(unsigned*)((unsigned char*)p.Aout + (size_t)row * D + 4 * lane + 256 * j) = pk4i8(av[j][0] * inv, av[j][1] * inv, av[j][2] * inv, av[j][3] * inv);
            } else
#pragma unroll
            for (int j = 0; j < 4; ++j) {
                av[j] = (xv[j] * rstd) * gsc[j] + shc[j];
                if constexpr (A8 == 1) *(unsigned*)((unsigned char*)p.Aout + (size_t)row * D + 4 * lane + 256 * j) = pk4f8(av[j][0], av[j][1], av[j][2], av[j][3]);
                else { u32x2 w; w.x = pk2h(av[j][0], av[j][1]); w.y = pk2h(av[j][2], av[j][3]);
                *(u32x2*)(p.Aout + (size_t)row * D + 4 * lane + 256 * j) = w; } }
            if constexpr (ROUTE) {
                float lg[8];
                { float sx[8] = {0.f, 0.f, 0.f, 0.f, 0.f, 0.f, 0.f, 0.f};
#pragma unroll
                  for (int c = 0; c < 16; ++c) { const float a = av[c >> 2][c & 3];
#pragma unroll
                      for (int e = 0; e < 8; ++e) sx[e] += a * rw[c][e >> 2][e & 3]; }
#pragma unroll
                  for (int i = 0; i < 4; ++i) { float t;
                      { auto r = __builtin_amdgcn_permlane32_swap(__float_as_uint(sx[2 * i]), __float_as_uint(sx[2 * i + 1]), false, false); t = __uint_as_float(r[0]) + __uint_as_float(r[1]); }
                      t += __builtin_bit_cast(float, __builtin_amdgcn_update_dpp(0, __builtin_bit_cast(int, t), 0x128, 0xF, 0xF, false));
                      t += __builtin_bit_cast(float, __builtin_amdgcn_update_dpp(0, __builtin_bit_cast(int, t), 0x124, 0xF, 0xF, false));
                      t += __builtin_bit_cast(float, __builtin_amdgcn_update_dpp(0, __builtin_bit_cast(int, t), 0x122, 0xF, 0xF, false));
                      t += __builtin_bit_cast(float, __builtin_amdgcn_update_dpp(0, __builtin_bit_cast(int, t), 0x121, 0xF, 0xF, false));
                      { auto r = __builtin_amdgcn_permlane16_swap(__float_as_uint(t), __float_as_uint(t), false, false); t = __uint_as_float(r[0]) + __uint_as_float(r[1]); }
                      lg[2 * i] = __builtin_bit_cast(float, __builtin_amdgcn_readlane(__builtin_bit_cast(int, t), 0)); lg[2 * i + 1] = __builtin_bit_cast(float, __builtin_amdgcn_readlane(__builtin_bit_cast(int, t), 32)); } }
                int e0 = 0; float l0 = lg[0];
#pragma unroll
                for (int e = 1; e < 8; ++e) if (lg[e] > l0) { l0 = lg[e]; e0 = e; }
                int e1 = -1; float l1 = -3.0e38f;
#pragma unroll
                for (int e = 0; e < 8; ++e) if (e != e0 && lg[e] > l1) { l1 = lg[e]; e1 = e; }
                const float w1 = 1.0f / (1.0f + expf(l0 - l1)), w0 = 1.0f - w1;
                if (lane == 0) { selb[2 * lr] = (unsigned char)e0; selb[2 * lr + 1] = (unsigned char)e1; p.gateout[2 * row] = w0; p.gateout[2 * row + 1] = w1; }
            }
        }
    }
    if constexpr (ROUTE) {
        __syncthreads();
        int nloc = p.nrows - rb0; nloc = nloc < 0 ? 0 : (nloc > rpb_ ? rpb_ : nloc);
        const int nent = 2 * nloc, e = F.wave;
        int total = 0;
        for (int base = 0; base < nent; base += 64) { const int n = base + lane; const bool f = (n < nent) && (selb[n] == (unsigned char)e); total += __popcll(__ballot(f)); }
        int gbase = 0;
        if (lane == 0 && total > 0) gbase = (int)__hip_atomic_fetch_add(p.cnt + e * 64, (unsigned)total, __ATOMIC_RELAXED, __HIP_MEMORY_SCOPE_AGENT);
        gbase = __builtin_amdgcn_readfirstlane(gbase);
        int run = 0;
        for (int base = 0; base < nent; base += 64) { const int n = base + lane; const bool f = (n < nent) && (selb[n] == (unsigned char)e);
            const unsigned long long m = __ballot(f); const int pre = __popcll(m & ((1ull << lane) - 1ull));
            if (f) p.list[(size_t)e * MR + gbase + run + pre] = (rb0 + (n >> 1)) * 2 + (n & 1);
            run += __popcll(m); }
        __syncthreads();
    }
}

DI void ld8(const f16* p, float (&v)[8]) { const u32x4 w = *(const u32x4*)p; const f32x2 a = unpk2h(w.x), b = unpk2h(w.y), c = unpk2h(w.z), d = unpk2h(w.w); v[0] = a[0]; v[1] = a[1]; v[2] = b[0]; v[3] = b[1]; v[4] = c[0]; v[5] = c[1]; v[6] = d[0]; v[7] = d[1]; }
DI void st8(f16* p, const float (&v)[8]) { u32x4 w; w.x = pk2h(v[0], v[1]); w.y = pk2h(v[2], v[3]); w.z = pk2h(v[4], v[5]); w.w = pk2h(v[6], v[7]); *(u32x4*)p = w; }
DI float seg_rstd(const float (&v)[8]) {
    float ss = 0.f;
#pragma unroll
    for (int j = 0; j < 8; ++j) ss += v[j] * v[j];
    ss += __shfl_xor(ss, 1); ss += __shfl_xor(ss, 2); ss += __shfl_xor(ss, 4);
    return 1.0f / sqrtf(ss * (1.0f / 64.0f) + EPS);
}
namespace att {
DI int crow(int r, int h) { return (r & 3) + 8 * (r >> 2) + 4 * h; }
DI f32x16 mfma32(f16x8 a, f16x8 b, f32x16 c) { return __builtin_amdgcn_mfma_f32_32x32x16_f16(a, b, c, 0, 0, 0); }
DI f32x16 mfma32b(bf16x8_t a, bf16x8_t b, f32x16 c) { return __builtin_amdgcn_mfma_f32_32x32x16_bf16(a, b, c, 0, 0, 0); }
DI f32x16 mfma64f8(i32x8 a, i32x8 b, f32x16 c) { return __builtin_amdgcn_mfma_scale_f32_32x32x64_f8f6f4(a, b, c, 0, 0, 0, 0, 0, 0); }
DI f32x16 mfma64f8_m4(i32x8 a, i32x8 b) { f32x16 d; asm volatile("v_mfma_f32_32x32x64_f8f6f4 %0, %1, %2, -4.0" : "=&v"(d) : "v"(a), "v"(b)); return d; }
DI s16x4 vtr(LAS const unsigned char* p) { return __builtin_bit_cast(s16x4, __builtin_amdgcn_ds_read_tr16_b64_v4i16((LAS v4i16_t*)p)); }

DI void glds16(const void* gsrc, unsigned lds_dst) { unsigned keep;
    asm volatile("s_mov_b32 %0, m0\n\ts_mov_b32 m0, %2\n\ts_nop 0\n\tglobal_load_lds_dwordx4 %1, off\n\ts_mov_b32 m0, %0" : "=&s"(keep) : "v"(gsrc), "s"(lds_dst) : "memory"); }
struct MaskNone { DI void apply(int, f32x16&, f32x16&, int, int) const {} };
struct MaskNA {
    int lo, rq, ch, wlo, NL; LAS const float* rpb;
    DI void apply(int t, f32x16& s0, f32x16& s1, int r, int h) const {
        if (t >= NL) return;
        const int kr = lo + t; const bool inwin = kr >= wlo && kr <= wlo + 7;
        int dr = kr - rq + 7; dr = dr < 0 ? 0 : (dr > 14 ? 14 : dr); LAS const float* tb = rpb + dr * 31;
        const int qcol = ch * 32 + r; int c0 = qcol - 8; c0 = c0 < 0 ? 0 : (c0 > 48 ? 48 : c0);
#pragma unroll
        for (int i = 0; i < 16; ++i) {
            const int k0 = crow(i, h), k1 = k0 + 32;
            { const bool ok = inwin && ((unsigned)(k0 - c0) < 16u); int dc = k0 - qcol + 15; dc = dc < 0 ? 0 : (dc > 30 ? 30 : dc); const float bv = tb[dc]; s0[i] = ok ? s0[i] + bv : -1.0e30f; }
            { const bool ok = inwin && ((unsigned)(k1 - c0) < 16u); int dc = k1 - qcol + 15; dc = dc < 0 ? 0 : (dc > 30 ? 30 : dc); const float bv = tb[dc]; s1[i] = ok ? s1[i] + bv : -1.0e30f; }
        }
    }
};
struct MaskSWA {
    int ka0, qa, NL;
    DI void apply(int t, f32x16& s0, f32x16& s1, int r, int h) const {
        if (t >= NL) return;
        const int du = ka0 + 64 * t - qa;
        if (du >= -97 && du <= 65) return;
        const int d0 = du - r;
#pragma unroll
        for (int i = 0; i < 16; ++i) { const int e0 = d0 + crow(i, h), e1 = e0 + 32;
            if (e0 > 128 || e0 < -128) s0[i] = -1.0e30f;
            if (e1 > 128 || e1 < -128) s1[i] = -1.0e30f; }
    }
};

#define ATT_SB() __builtin_amdgcn_sched_barrier(0)
template <int NK, int DV, class Mask, int VAR = 0>
DI void attn_core(Frame& F, const f16* P, int pitch, int qrow, int qcol, const unsigned char* K8h, const unsigned char* V8h, int kmap, int NL, int Lrow0, int Crow0,
                  float negoff, const Mask& M, f32x16 (&o)[DV / 32], f32x16& osum) {
    static_assert(DV == 128, "fp8 V image: 128 columns");
    static_assert(NK == 2, "fp8 K image: two maps");
    constexpr int NC = DV / 32, KSLOT = 8192, VSLOT = 8192, VRING = 4 * KSLOT;
    const int lane = F.lane, wid = F.wave, r = lane & 31, h = lane >> 5;
    const int NT = NL + 4;
    LAS unsigned char* lds = F.lds;
    const unsigned lds0 = (unsigned)(unsigned long)F.lds;
    i32x8 q;
    { const f16* qp = P + (size_t)(qrow + r) * pitch + qcol + 32 * h;
#pragma unroll
      for (int d0 = 0; d0 < 4; ++d0) { const u32x4 w = *(const u32x4*)(qp + 8 * d0); const f32x2 a = unpk2h(w.x), b = unpk2h(w.y), c = unpk2h(w.z), d = unpk2h(w.w);
          q[2 * d0] = (int)pk4f8(a[0], a[1], b[0], b[1]); q[2 * d0 + 1] = (int)pk4f8(c[0], c[1], d[0], d[1]); } }
#pragma unroll
    for (int c = 0; c < NC; ++c)
#pragma unroll
        for (int i = 0; i < 16; ++i) o[c][i] = 0.f;
#pragma unroll
    for (int i = 0; i < 16; ++i) osum[i] = 0.f;
    i32x8 ones;
#pragma unroll
    for (int i = 0; i < 8; ++i) { int x; asm volatile("v_mov_b32 %0, 0x38383838" : "=v"(x)); ones[i] = x; }
    const f32x16 zero16 = {-4.f, -4.f, -4.f, -4.f, -4.f, -4.f, -4.f, -4.f, -4.f, -4.f, -4.f, -4.f, -4.f, -4.f, -4.f, -4.f};
    const int koff = kmap * 4096 + (h * 64 + r) * 16;
    const unsigned char* kg = K8h + wid * 1024 + lane * 16;
    const int voff = VRING + (h * 128 + r) * 16;
    const unsigned char* vg = V8h + wid * 1024 + lane * 16;
    const char* Pb = (const char*)P;
#define ATT_TROW(j) ({ int j_ = (j) < NT ? (j) : NT - 1; (j_ < NL) ? (Lrow0 + 64 * j_) : (Crow0 + 64 * (j_ - NL)); })
#define ATT_DMA_K(j, slot) do { glds16(kg + ((size_t)(ATT_TROW(j) >> 6) << 13), (unsigned)__builtin_amdgcn_readfirstlane((int)(lds0 + (slot) * KSLOT + wid * 1024))); } while (0)
#define ATT_LDK(kb) do { const u32x4 k0_ = *(LAS const u32x4*)((kb) + koff), k1_ = *(LAS const u32x4*)((kb) + koff + 2048), k2_ = *(LAS const u32x4*)((kb) + koff + 512), k3_ = *(LAS const u32x4*)((kb) + koff + 2560); \
        kfa = __builtin_bit_cast(i32x8, __builtin_shufflevector(k0_, k1_, 0, 1, 2, 3, 4, 5, 6, 7)); kfb = __builtin_bit_cast(i32x8, __builtin_shufflevector(k2_, k3_, 0, 1, 2, 3, 4, 5, 6, 7)); } while (0)
#define ATT_DMA_V(j, slot) do { glds16(vg + ((size_t)(ATT_TROW(j) >> 6) << 13), (unsigned)__builtin_amdgcn_readfirstlane((int)(lds0 + VRING + (slot) * VSLOT + wid * 1024))); } while (0)
#define ATT_WAITV(n) asm volatile("s_waitcnt vmcnt(%0)" :: "n"(n) : "memory")
#define ATT_BARRIER() do { asm volatile("s_waitcnt lgkmcnt(0)" ::: "memory"); __builtin_amdgcn_s_barrier(); asm volatile("" ::: "memory"); } while (0)
    ATT_DMA_K(0, 0); ATT_DMA_V(0, 0); ATT_DMA_K(1, 1); ATT_DMA_V(1, 1); ATT_DMA_K(2, 2);
    ATT_WAITV(0); ATT_BARRIER();
    f32x16 c0 = zero16, c1 = zero16;
    { i32x8 kfa, kfb; ATT_LDK(lds); c0 = mfma64f8(kfa, q, c0); c1 = mfma64f8(kfb, q, c1); }
    ATT_BARRIER();
    M.apply(0, c0, c1, r, h);
#pragma unroll
    for (int i = 0; i < 12; ++i) { c0[i] = fast_exp2(c0[i]); c1[i] = fast_exp2(c1[i]); }
    f32x16 n0, n1;
#define ATT_RD(buf, c) do { va[buf][0] = *(LAS const u32x4*)(vb + (c) * 512); va[buf][1] = *(LAS const u32x4*)(vb + (c) * 512 + 4096); } while (0)
#define ATT_MM(buf, c) do { const i32x8 bfrag = __builtin_bit_cast(i32x8, __builtin_shufflevector(va[buf][0], va[buf][1], 0, 1, 2, 3, 4, 5, 6, 7)); o[c] = mfma64f8(pf, bfrag, o[c]); } while (0)
    i32x8 kfa, kfb;
    { LAS const unsigned char* kb1 = lds + KSLOT; ATT_LDK(kb1); }
#define ATT_E(x) x = fast_exp2(x)
#define ATT_STEP(CA, CB, NA, NB, tt, ISSUE, SYNC) do { \
        const int vs0 = (tt) & 3; \
        if (ISSUE) { ATT_DMA_K((tt) + 3, ((tt) + 3) & 3); ATT_DMA_V((tt) + 2, ((tt) + 2) & 3); ATT_DMA_K((tt) + 4, (tt) & 3); ATT_DMA_V((tt) + 3, ((tt) + 3) & 3); } \
        i32x8 pf; \
        LAS const unsigned char* vb = lds + voff + vs0 * VSLOT; \
        u32x4 va[2][2]; \
        ATT_RD(0, 0); ATT_RD(1, 1); \
        ATT_SB(); \
          \
        NA = mfma64f8_m4(kfa, q); ATT_SB(); \
        ATT_E(CA[12]); ATT_E(CB[12]); ATT_E(CA[13]); ATT_E(CB[13]); \
        _Pragma("unroll") for (int i = 0; i < 4; ++i) pf[i] = (int)pk4f8(CA[i], CA[8 + i], CB[i], CB[8 + i]); \
        ATT_SB(); \
        NB = mfma64f8_m4(kfb, q); ATT_SB(); \
        ATT_E(CA[14]); ATT_E(CB[14]); ATT_E(CA[15]); ATT_E(CB[15]); \
        _Pragma("unroll") for (int i = 4; i < 8; ++i) pf[i] = (int)pk4f8(CA[i], CA[8 + i], CB[i], CB[8 + i]); \
        ATT_SB(); \
        M.apply((tt) + 1, NA, NB, r, h); \
          \
        ATT_MM(0, 0); ATT_SB(); ATT_E(NA[0]); ATT_E(NA[1]); ATT_E(NA[2]); ATT_E(NA[3]); ATT_E(NA[4]); ATT_E(NA[5]); ATT_SB(); \
        ATT_RD(0, 2); ATT_SB(); \
        ATT_MM(1, 1); ATT_SB(); ATT_E(NA[6]); ATT_E(NA[7]); ATT_E(NA[8]); ATT_E(NA[9]); ATT_E(NA[10]); ATT_E(NA[11]); ATT_SB(); \
        ATT_RD(1, 3); if (!(SYNC)) { LAS const unsigned char* kb2 = lds + (((tt) + 2) & 3) * KSLOT; ATT_LDK(kb2); } ATT_SB(); \
        ATT_MM(0, 2); ATT_SB(); ATT_E(NB[0]); ATT_E(NB[1]); ATT_E(NB[2]); ATT_E(NB[3]); ATT_E(NB[4]); ATT_E(NB[5]); ATT_SB(); \
        if (SYNC) { ATT_WAITV(0); ATT_BARRIER(); { LAS const unsigned char* kb2 = lds + (((tt) + 2) & 3) * KSLOT; ATT_LDK(kb2); } ATT_SB(); } \
        ATT_MM(1, 3); ATT_SB(); ATT_E(NB[6]); ATT_E(NB[7]); ATT_E(NB[8]); ATT_SB(); \
        osum = mfma64f8(pf, ones, osum); ATT_SB(); ATT_E(NB[9]); ATT_E(NB[10]); ATT_E(NB[11]); ATT_SB(); \
    } while (0)
    int t = 0;
    for (; t + 1 < NT; t += 2) { ATT_STEP(c0, c1, n0, n1, t, true, false); ATT_STEP(n0, n1, c0, c1, t + 1, false, true); }
    if (t < NT) ATT_STEP(c0, c1, n0, n1, t, false, true);
#undef ATT_E
#undef ATT_STEP
#undef ATT_RD
#undef ATT_MM
    ATT_WAITV(0);
    ATT_BARRIER();
#undef ATT_TROW
#undef ATT_DMA_K
#undef ATT_LDK
#undef ATT_DMA_V
#undef ATT_WAITV
#undef ATT_BARRIER
}
#undef ATT_SB


#define SW8_SB() __builtin_amdgcn_sched_barrier(0)
template <class Mask>
DI void attn_core_swa8(Frame& F, const f16* P, int pitch, int qrow, int qcol, const unsigned char* K8h, const unsigned char* V8h, int NL, int Lrow0, int Crow0,
                       const Mask& M, f32x16 (&o)[2], f32x16& osum) {
    constexpr int KSLOT = 4096, VSLOT = 4096, VRING = 4 * KSLOT;
    const int lane = F.lane, wid = F.wave, r = lane & 31, h = lane >> 5;
    const int NT = NL + 4;
    LAS unsigned char* lds = F.lds;
    const unsigned lds0 = (unsigned)(unsigned long)F.lds;
    i32x8 q;
    { const f16* qp = P + (size_t)(qrow + r) * pitch + qcol + 32 * h;
#pragma unroll
      for (int d0 = 0; d0 < 4; ++d0) { const u32x4 w = *(const u32x4*)(qp + 8 * d0); const f32x2 a = unpk2h(w.x), b = unpk2h(w.y), c = unpk2h(w.z), d = unpk2h(w.w);
          q[2 * d0] = (int)pk4f8(a[0], a[1], b[0], b[1]); q[2 * d0 + 1] = (int)pk4f8(c[0], c[1], d[0], d[1]); } }
#pragma unroll
    for (int i = 0; i < 16; ++i) { o[0][i] = 0.f; o[1][i] = 0.f; osum[i] = 0.f; }
    i32x8 ones;
#pragma unroll
    for (int i = 0; i < 8; ++i) { int x; asm volatile("v_mov_b32 %0, 0x38383838" : "=v"(x)); ones[i] = x; }
    const f32x16 zero16 = {-4.f, -4.f, -4.f, -4.f, -4.f, -4.f, -4.f, -4.f, -4.f, -4.f, -4.f, -4.f, -4.f, -4.f, -4.f, -4.f};
    const int koff = (h * 64 + r) * 16;
    const int voff = VRING + (h * 64 + r) * 16;
    const bool kw = wid < 4;
    const unsigned char* gsrc = (kw ? K8h : V8h) + (wid & 3) * 1024 + lane * 16;
#define SW8_TROW(j) ({ int j_ = (j) < NT ? (j) : NT - 1; (j_ < NL) ? (Lrow0 + 64 * j_) : (Crow0 + 64 * (j_ - NL)); })
#define SW8_DMA(jk, sk, jv, sv) do { const int j__ = kw ? (jk) : (jv); const int dst__ = kw ? (sk) * KSLOT : VRING + (sv) * VSLOT; \
        glds16(gsrc + ((size_t)(SW8_TROW(j__) >> 6) << 12), (unsigned)__builtin_amdgcn_readfirstlane((int)(lds0 + dst__ + (wid & 3) * 1024))); } while (0)
#define SW8_LDK(kb) do { const u32x4 k0_ = *(LAS const u32x4*)((kb) + koff), k1_ = *(LAS const u32x4*)((kb) + koff + 2048), k2_ = *(LAS const u32x4*)((kb) + koff + 512), k3_ = *(LAS const u32x4*)((kb) + koff + 2560); \
        kfa = __builtin_bit_cast(i32x8, __builtin_shufflevector(k0_, k1_, 0, 1, 2, 3, 4, 5, 6, 7)); kfb = __builtin_bit_cast(i32x8, __builtin_shufflevector(k2_, k3_, 0, 1, 2, 3, 4, 5, 6, 7)); } while (0)
#define SW8_WAITV(n) asm volatile("s_waitcnt vmcnt(%0)" :: "n"(n) : "memory")
#define SW8_BARRIER() do { asm volatile("s_waitcnt lgkmcnt(0)" ::: "memory"); __builtin_amdgcn_s_barrier(); asm volatile("" ::: "memory"); } while (0)
    SW8_DMA(0, 0, 0, 0); SW8_DMA(1, 1, 1, 1); if (kw) SW8_DMA(2, 2, 2, 2);
    SW8_WAITV(0); SW8_BARRIER();
    f32x16 c0 = zero16, c1 = zero16;
    { i32x8 kfa, kfb; SW8_LDK(lds); c0 = mfma64f8(kfa, q, c0); c1 = mfma64f8(kfb, q, c1); }
    SW8_BARRIER();
    M.apply(0, c0, c1, r, h);
#pragma unroll
    for (int i = 0; i < 12; ++i) { c0[i] = fast_exp2(c0[i]); c1[i] = fast_exp2(c1[i]); }
    f32x16 n0, n1;
#define SW8_RD(buf, c) do { va[buf][0] = *(LAS const u32x4*)(vb + (c) * 512); va[buf][1] = *(LAS const u32x4*)(vb + (c) * 512 + 2048); } while (0)
#define SW8_MM(buf, c) do { const i32x8 bfrag = __builtin_bit_cast(i32x8, __builtin_shufflevector(va[buf][0], va[buf][1], 0, 1, 2, 3, 4, 5, 6, 7)); o[c] = mfma64f8(pf, bfrag, o[c]); } while (0)
    i32x8 kfa, kfb;
    { LAS const unsigned char* kb1 = lds + KSLOT; SW8_LDK(kb1); }
#define SW8_E(x) x = fast_exp2(x)
#define SW8_STEP(CA, CB, NA, NB, tt, ISSUE, SYNC) do { \
        const int vs0 = (tt) & 3; \
        if (ISSUE) { SW8_DMA((tt) + 3, ((tt) + 3) & 3, (tt) + 2, ((tt) + 2) & 3); SW8_DMA((tt) + 4, (tt) & 3, (tt) + 3, ((tt) + 3) & 3); } \
        i32x8 pf; \
        LAS const unsigned char* vb = lds + voff + vs0 * VSLOT; \
        u32x4 va[2][2]; \
        SW8_RD(0, 0); SW8_RD(1, 1); \
        SW8_SB(); \
        NA = mfma64f8_m4(kfa, q); SW8_SB(); \
        SW8_E(CA[12]); SW8_E(CB[12]); SW8_E(CA[13]); SW8_E(CB[13]); \
        _Pragma("unroll") for (int i = 0; i < 4; ++i) pf[i] = (int)pk4f8(CA[i], CA[8 + i], CB[i], CB[8 + i]); \
        SW8_SB(); \
        NB = mfma64f8_m4(kfb, q); SW8_SB(); \
        SW8_E(CA[14]); SW8_E(CB[14]); SW8_E(CA[15]); SW8_E(CB[15]); \
        _Pragma("unroll") for (int i = 4; i < 8; ++i) pf[i] = (int)pk4f8(CA[i], CA[8 + i], CB[i], CB[8 + i]); \
        SW8_SB(); \
        SW8_MM(0, 0); SW8_SB(); \
        M.apply((tt) + 1, NA, NB, r, h); \
        SW8_E(NA[0]); SW8_E(NA[1]); SW8_E(NA[2]); SW8_E(NA[3]); SW8_E(NA[4]); SW8_E(NA[5]); SW8_E(NA[6]); SW8_E(NA[7]); \
        if (!(SYNC)) { LAS const unsigned char* kb2 = lds + (((tt) + 2) & 3) * KSLOT; SW8_LDK(kb2); } SW8_SB(); \
        SW8_MM(1, 1); SW8_SB(); SW8_E(NA[8]); SW8_E(NA[9]); SW8_E(NA[10]); SW8_E(NA[11]); SW8_E(NB[0]); SW8_E(NB[1]); SW8_E(NB[2]); SW8_E(NB[3]); SW8_SB(); \
        if (SYNC) { SW8_WAITV(0); SW8_BARRIER(); { LAS const unsigned char* kb2 = lds + (((tt) + 2) & 3) * KSLOT; SW8_LDK(kb2); } SW8_SB(); } \
        osum = mfma64f8(pf, ones, osum); SW8_SB(); SW8_E(NB[4]); SW8_E(NB[5]); SW8_E(NB[6]); SW8_E(NB[7]); SW8_E(NB[8]); SW8_E(NB[9]); SW8_E(NB[10]); SW8_E(NB[11]); SW8_SB(); \
    } while (0)
    int t = 0;
    for (; t + 1 < NT; t += 2) { SW8_STEP(c0, c1, n0, n1, t, true, false); SW8_STEP(n0, n1, c0, c1, t + 1, false, true); }
    if (t < NT) SW8_STEP(c0, c1, n0, n1, t, false, true);
#undef SW8_E
#undef SW8_STEP
#undef SW8_RD
#undef SW8_MM
    SW8_WAITV(0);
    SW8_BARRIER();
#undef SW8_TROW
#undef SW8_DMA
#undef SW8_LDK
#undef SW8_WAITV
#undef SW8_BARRIER
}
#undef SW8_SB

template <int NK, int DV> struct TileRegsRS { u32x4 k[NK]; u32x4 v[DV / 64]; };
constexpr int KTB_RS = 64 * 144;
template <int NK, int DV> constexpr int tile_bytes_rs() { return NK * KTB_RS + DV * 128; }

template <int NK, int DV>
DI void tile_load_rs(TileRegsRS<NK, DV>& R, const f16* P, int pitch, int row0, const int (&kcol)[NK], int vcol, int wid, int lane) {
    const f16* kp = P + (size_t)(row0 + 8 * wid + (lane >> 3)) * pitch + (lane & 7) * 8;
#pragma unroll
    for (int m = 0; m < NK; ++m) R.k[m] = *(const u32x4*)(kp + kcol[m]);
#pragma unroll
    for (int i = 0; i < DV / 64; ++i) { const int pi = wid + 8 * i, c = pi >> 2, rg = pi & 3;
        R.v[i] = *(const u32x4*)(P + (size_t)(row0 + 16 * rg + (lane >> 2)) * pitch + vcol + 32 * c + 8 * (lane & 3)); }
}
template <int NK, int DV>
DI void tile_store_rs(const TileRegsRS<NK, DV>& R, LAS unsigned char* buf, int wid, int lane) {
#pragma unroll
    for (int m = 0; m < NK; ++m) *(LAS u32x4*)(buf + m * KTB_RS + (8 * wid + (lane >> 3)) * 144 + (lane & 7) * 16) = R.k[m];
#pragma unroll
    for (int i = 0; i < DV / 64; ++i) { const int pi = wid + 8 * i; *(LAS u32x4*)(buf + NK * KTB_RS + pi * 1024 + lane * 16) = R.v[i]; }
}

template <class M_> DI float rs_softmax_all(const M_& M, int t, f32x16& s0, f32x16& s1, int r, int h) {
    M.apply(t, s0, s1, r, h); float ls = 0.f;
#pragma unroll
    for (int i = 0; i < 16; ++i) { s0[i] = fast_exp2(s0[i]); s1[i] = fast_exp2(s1[i]); ls += s0[i] + s1[i]; }
    return ls; }
struct MaskNoneRS { DI bool active(int) const { return true; } DI void apply(int, f32x16&, f32x16&, int, int) const {} DI float softmax(int t, f32x16& s0, f32x16& s1, int r, int h) const { return rs_softmax_all(*this, t, s0, s1, r, h); } };
struct MaskNARS {
    int lo, rq, ch, wlo, NL; LAS const float* rpb;
    DI bool active(int t) const { if (t >= NL) return true; const int kr = lo + t; return kr >= wlo && kr <= wlo + 7; }
    DI void apply(int t, f32x16& s0, f32x16& s1, int r, int h) const {
        if (t >= NL) return;
        const int dr = lo + t - rq + 7;
        const int qcol = ch * 32 + r; int c0 = qcol - 8; c0 = c0 < 0 ? 0 : (c0 > 48 ? 48 : c0);
        LAS const float* tb = rpb + (dr * 31 + 15 + 4 * h - qcol);
#pragma unroll
        for (int i = 0; i < 16; ++i) {
            const int kc = (i & 3) + 8 * (i >> 2);
            const int k0 = kc + 4 * h, k1 = k0 + 32;
            { const bool ok = (unsigned)(k0 - c0) < 16u; const float bv = tb[kc];      s0[i] = ok ? s0[i] + bv : -1.0e30f; }
            { const bool ok = (unsigned)(k1 - c0) < 16u; const float bv = tb[kc + 32]; s1[i] = ok ? s1[i] + bv : -1.0e30f; }
        }
    }
    DI float softmax(int t, f32x16& s0, f32x16& s1, int r, int h) const {
        if (t >= NL) return rs_softmax_all(*this, t, s0, s1, r, h);
        const int dr = lo + t - rq + 7;
        const int qcol = ch * 32 + r; int c0 = qcol - 8; c0 = c0 < 0 ? 0 : (c0 > 48 ? 48 : c0);
        LAS const float* tb = rpb + (dr * 31 + 15 + 4 * h - qcol);
        float ls = 0.f;
        if (ch == 0) {
            float b0[16], b1[4];
#pragma unroll
            for (int i = 0; i < 16; ++i) b0[i] = tb[(i & 3) + 8 * (i >> 2)];
#pragma unroll
            for (int i = 0; i < 4; ++i) b1[i] = tb[(i & 3) + 8 * (i >> 2) + 32];
            asm volatile("" : "+v"(b0[0]), "+v"(b0[1]), "+v"(b0[2]), "+v"(b0[3]), "+v"(b0[4]), "+v"(b0[5]), "+v"(b0[6]), "+v"(b0[7]), "+v"(b0[8]), "+v"(b0[9]));
            asm volatile("" : "+v"(b0[10]), "+v"(b0[11]), "+v"(b0[12]), "+v"(b0[13]), "+v"(b0[14]), "+v"(b0[15]), "+v"(b1[0]), "+v"(b1[1]), "+v"(b1[2]), "+v"(b1[3]));
#pragma unroll
            for (int i = 0; i < 16; ++i) { const int k0 = (i & 3) + 8 * (i >> 2) + 4 * h;
                const bool ok = (unsigned)(k0 - c0) < 16u; s0[i] = fast_exp2(ok ? s0[i] + b0[i] : -1.0e30f); ls += s0[i]; }
#pragma unroll
            for (int i = 0; i < 4; ++i) { const int k1 = (i & 3) + 8 * (i >> 2) + 4 * h + 32;
                const bool ok = (unsigned)(k1 - c0) < 16u; s1[i] = fast_exp2(ok ? s1[i] + b1[i] : -1.0e30f); ls += s1[i]; }
#pragma unroll
            for (int i = 4; i < 16; ++i) s1[i] = 0.f;
        } else {
            float b0[4], b1[16];
#pragma unroll
            for (int i = 0; i < 4; ++i) b0[i] = tb[((12 + i) & 3) + 8 * ((12 + i) >> 2)];
#pragma unroll
            for (int i = 0; i < 16; ++i) b1[i] = tb[(i & 3) + 8 * (i >> 2) + 32];
            asm volatile("" : "+v"(b1[0]), "+v"(b1[1]), "+v"(b1[2]), "+v"(b1[3]), "+v"(b1[4]), "+v"(b1[5]), "+v"(b1[6]), "+v"(b1[7]), "+v"(b1[8]), "+v"(b1[9]));
            asm volatile("" : "+v"(b1[10]), "+v"(b1[11]), "+v"(b1[12]), "+v"(b1[13]), "+v"(b1[14]), "+v"(b1[15]), "+v"(b0[0]), "+v"(b0[1]), "+v"(b0[2]), "+v"(b0[3]));
#pragma unroll
            for (int i = 12; i < 16; ++i) { const int k0 = (i & 3) + 8 * (i >> 2) + 4 * h;
                const bool ok = (unsigned)(k0 - c0) < 16u; s0[i] = fast_exp2(ok ? s0[i] + b0[i - 12] : -1.0e30f); ls += s0[i]; }
#pragma unroll
            for (int i = 0; i < 12; ++i) s0[i] = 0.f;
#pragma unroll
            for (int i = 0; i < 16; ++i) { const int k1 = (i & 3) + 8 * (i >> 2) + 4 * h + 32;
                const bool ok = (unsigned)(k1 - c0) < 16u; s1[i] = fast_exp2(ok ? s1[i] + b1[i] : -1.0e30f); ls += s1[i]; }
        }
        return ls;
    }
};
struct MaskSWARS {
    int ka0, qa, NL;
    DI bool active(int t) const { if (t >= NL) return true; const int ka = ka0 + 64 * t; return (ka <= qa + 31 + 128) && (ka + 63 >= qa - 128); }
    DI void apply(int t, f32x16& s0, f32x16& s1, int r, int h) const {
        if (t >= NL) return;
        const int d0 = ka0 + 64 * t - (qa + r);
#pragma unroll
        for (int i = 0; i < 16; ++i) { const int e0 = d0 + crow(i, h), e1 = e0 + 32;
            if (e0 > 128 || e0 < -128) s0[i] = -1.0e30f;
            if (e1 > 128 || e1 < -128) s1[i] = -1.0e30f; }
    }
    DI float softmax(int t, f32x16& s0, f32x16& s1, int r, int h) const { return rs_softmax_all(*this, t, s0, s1, r, h); }
};

#define ATT_BAR_RS() do { asm volatile("s_waitcnt lgkmcnt(0)" ::: "memory"); __builtin_amdgcn_s_barrier(); asm volatile("" ::: "memory"); } while (0)
template <int NK, int DV, class Mask>
DI void attn_core_rs(Frame& F, const f16* P, int pitch, int qrow, int qcol, const int (&kcol)[NK], int vcol, int kmap, int NL, int Lrow0, int Crow0,
                  float negoff, const Mask& M, f32x16 (&o)[DV / 32], float& lsum) {
    constexpr int TB = tile_bytes_rs<NK, DV>();
    const int lane = F.lane, wid = F.wave, r = lane & 31, h = lane >> 5;
    const int NT = NL + 4;
    const bool trailing = false;
    f16x8 q[4];
    { const f16* qp = P + (size_t)(qrow + r) * pitch + qcol + 8 * h;
#pragma unroll
      for (int d0 = 0; d0 < 4; ++d0) q[d0] = *(const f16x8*)(qp + 16 * d0); }
#pragma unroll
    for (int c = 0; c < DV / 32; ++c)
#pragma unroll
        for (int i = 0; i < 16; ++i) o[c][i] = 0.f;
    lsum = 0.f;
    f32x16 init;
#pragma unroll
    for (int i = 0; i < 16; ++i) init[i] = negoff;
    TileRegsRS<NK, DV> RA, RB;
#define RS_TROW(j) (((j) < NL) ? (Lrow0 + 64 * (j)) : (Crow0 + 64 * ((j) - NL)))
    tile_load_rs<NK, DV>(RA, P, pitch, RS_TROW(0), kcol, vcol, wid, lane);
    tile_store_rs<NK, DV>(RA, F.lds, wid, lane);
    tile_load_rs<NK, DV>(RB, P, pitch, RS_TROW(1), kcol, vcol, wid, lane);
    tile_load_rs<NK, DV>(RA, P, pitch, RS_TROW(2), kcol, vcol, wid, lane);
    ATT_BAR_RS();
    const int voff = (4 * h + ((lane & 15) >> 2)) * 64 + ((lane >> 4) & 1) * 32 + (lane & 3) * 8;
    int bcur = 0, bnext = TB;
    constexpr int NC = DV / 32;
#define RS_RD(slot, ks) do { _Pragma("unroll") for (int c = 0; c < NC; ++c) { vv[slot][2 * c] = vtr(vb + c * 4096 + (ks) * 1024); vv[slot][2 * c + 1] = vtr(vb + c * 4096 + (ks) * 1024 + 512); } } while (0)
#define RS_MM(slot, ks) do { _Pragma("unroll") for (int c = 0; c < NC; ++c) { \
        const bf16x8_t bfrag = __builtin_bit_cast(bf16x8_t, __builtin_shufflevector(vv[slot][2 * c], vv[slot][2 * c + 1], 0, 1, 2, 3, 4, 5, 6, 7)); o[c] = mfma32b(pf[ks], bfrag, o[c]); } } while (0)
#define RS_SB() __builtin_amdgcn_sched_barrier(0)
#define RS_STEP(tt, RN) do { \
        LAS unsigned char* buf = F.lds + bcur; \
        if ((tt) + 1 < NT) { \
            tile_store_rs<NK, DV>(RN, F.lds + bnext, wid, lane); \
            if ((tt) + 3 < NT) tile_load_rs<NK, DV>(RN, P, pitch, RS_TROW((tt) + 3), kcol, vcol, wid, lane); \
        } \
        if (M.active(tt)) { \
            bf16x8_t pf[4]; \
            f32x16 s0 = init, s1 = init; \
            f16x8 kf[8]; \
            { LAS const unsigned char* kb = buf + kmap * KTB_RS + r * 144 + h * 16; \
              _Pragma("unroll") for (int d0 = 0; d0 < 4; ++d0) { kf[2 * d0] = *(LAS const f16x8*)(kb + d0 * 32); kf[2 * d0 + 1] = *(LAS const f16x8*)(kb + d0 * 32 + 32 * 144); } } \
            RS_SB(); \
            _Pragma("unroll") for (int d0 = 0; d0 < 4; ++d0) { s0 = mfma32(kf[2 * d0], q[d0], s0); s1 = mfma32(kf[2 * d0 + 1], q[d0], s1); } \
            lsum += M.softmax((tt), s0, s1, r, h); \
            _Pragma("unroll") for (int s_ = 0; s_ < 2; ++s_) { \
                u32x4 w0, w1; \
                w0.x = pk2bf(s0[8 * s_ + 0], s0[8 * s_ + 1]); w0.y = pk2bf(s0[8 * s_ + 2], s0[8 * s_ + 3]); w0.z = pk2bf(s0[8 * s_ + 4], s0[8 * s_ + 5]); w0.w = pk2bf(s0[8 * s_ + 6], s0[8 * s_ + 7]); \
                w1.x = pk2bf(s1[8 * s_ + 0], s1[8 * s_ + 1]); w1.y = pk2bf(s1[8 * s_ + 2], s1[8 * s_ + 3]); w1.z = pk2bf(s1[8 * s_ + 4], s1[8 * s_ + 5]); w1.w = pk2bf(s1[8 * s_ + 6], s1[8 * s_ + 7]); \
                pf[s_] = __builtin_bit_cast(bf16x8_t, w0); pf[2 + s_] = __builtin_bit_cast(bf16x8_t, w1); \
            } \
            RS_SB(); \
            LAS const unsigned char* vb = buf + NK * KTB_RS + voff; \
            s16x4 vv[2][2 * NC]; \
            RS_RD(0, 0); RS_RD(1, 1); RS_SB(); RS_MM(0, 0); RS_SB(); RS_RD(0, 2); RS_SB(); RS_MM(1, 1); RS_SB(); RS_RD(1, 3); RS_SB(); RS_MM(0, 2); RS_SB(); RS_MM(1, 3); RS_SB(); \
        } \
        ATT_BAR_RS();                                   \
        bcur = bnext; bnext = (bnext == 2 * TB) ? 0 : bnext + TB; \
    } while (0)
    { int t = 0; for (; t + 1 < NT; t += 2) { RS_STEP(t, RB); RS_STEP(t + 1, RA); } if (t < NT) RS_STEP(t, RB); }
#undef RS_STEP
#undef RS_RD
#undef RS_MM
#undef RS_SB
#undef RS_TROW
    ATT_BAR_RS();
}

DI void epi64(Frame& F, const f32x16 (&o)[2], float lsum, float extra, f16* Y, int qrow, int ycol) {
    const int lane = F.lane, wid = F.wave, r = lane & 31, h = lane >> 5;
    LAS float* wsf = (LAS float*)(F.lds + ATT_WSF) + wid * 64;
    float l = sum_xor32(lsum) + extra;
    if (h == 0) wsf[r] = l;
    float rli[16];
#pragma unroll
    for (int i = 0; i < 16; ++i) rli[i] = fast_rcp(wsf[crow(i, h)]);
    LAS f16* stg = (LAS f16*)(F.lds + ATT_STG) + wid * 2048;
#pragma unroll
    for (int i = 0; i < 16; ++i) { const int orow = crow(i, h);
#pragma unroll
        for (int c = 0; c < 2; ++c) stg[orow * 64 + c * 32 + r] = (f16)(o[c][i] * rli[i]); }
#pragma unroll
    for (int i = 0; i < 4; ++i) { const int row = i * 8 + (lane >> 3), ch = lane & 7; const u32x4 v = *(const LAS u32x4*)(stg + row * 64 + ch * 8);
        *(u32x4*)(Y + (size_t)(qrow + row) * D + ycol + ch * 8) = v; }
}
DI void epi64s(Frame& F, const f32x16 (&o)[2], const f32x16& osum, float extra, f16* Y, int qrow, int ycol) {
    const int lane = F.lane, wid = F.wave, r = lane & 31, h = lane >> 5;
    LAS f16* stg = (LAS f16*)(F.lds + ATT_STG) + wid * 2048;
#pragma unroll
    for (int i = 0; i < 16; ++i) { const int orow = crow(i, h); const float rl = fast_rcp(osum[i] + extra);
#pragma unroll
        for (int c = 0; c < 2; ++c) stg[orow * 64 + c * 32 + r] = (f16)(o[c][i] * rl); }
#pragma unroll
    for (int i = 0; i < 4; ++i) { const int row = i * 8 + (lane >> 3), ch = lane & 7; const u32x4 v = *(const LAS u32x4*)(stg + row * 64 + ch * 8);
        *(u32x4*)(Y + (size_t)(qrow + row) * D + ycol + ch * 8) = v; }
}
}

DI void conv_even(const Frame& F0, const f16* P, f16* Y, const float* convw  ) {
    Frame F = phase_frame(F0);
    const int gw = F.vcu * NWAVES + F.wave, NGW = F.G * NWAVES, lane = F.lane, c0 = 8 * lane;
    float w0[8], w1[8], w2[8];
#pragma unroll
    for (int j = 0; j < 8; ++j) { w0[j] = convw[c0 + j]; w1[j] = convw[512 + c0 + j]; w2[j] = convw[1024 + c0 + j]; }
    for (int row = gw; row < MR; row += NGW) {
        const f16* pr = P + (size_t)row * EVN;
        const int n = row < T ? SEQ : CTXL, tp = row < T ? (row & (SEQ - 1)) : ((row - T) & (CTXL - 1));
        float gb[8], gc[8], uu[8], gcm[8], um[8], gcp[8], up[8], y[8];
        ld8(pr + c0, gb); ld8(pr + 512 + c0, gc); ld8(pr + 1024 + c0, uu);
        if (tp > 0) { ld8(pr - EVN + 512 + c0, gcm); ld8(pr - EVN + 1024 + c0, um); } else {
#pragma unroll
            for (int j = 0; j < 8; ++j) { gcm[j] = 0.f; um[j] = 0.f; } }
        if (tp < n - 1) { ld8(pr + EVN + 512 + c0, gcp); ld8(pr + EVN + 1024 + c0, up); } else {
#pragma unroll
            for (int j = 0; j < 8; ++j) { gcp[j] = 0.f; up[j] = 0.f; } }
#pragma unroll
        for (int j = 0; j < 8; ++j) y[j] = gb[j] * (w0[j] * (gcm[j] * um[j]) + w1[j] * (gc[j] * uu[j]) + w2[j] * (gcp[j] * up[j]));
        st8(Y + (size_t)row * D + c0, y);
    }
}
DI void attn_even(const Frame& F0, const f16* P, f16* Y, const float* qg, const float* kg, const float* rpb  ) {
    Frame F = phase_frame(F0);
    using namespace att;
    const float negoff = 0.f;
    LAS float* rl = (LAS float*)(F.lds + ATT_RPB);
    for (int i = F.tid; i < 8 * 465; i += NTHREADS) rl[i] = rpb[i] * LOG2E;
    __syncthreads();
    const int w = F.wave;
    for (int u = F.vcu; u < 1024 + 32; u += F.G) {
        f32x16 o[2]; float lsum;
        int qrow, hh;
        if (u < 1024) {
            const int bh = u >> 5, j = u & 31, b = bh >> 3; hh = bh & 7;
            const int R0 = 4 * j, rq = R0 + (w >> 1), ch = w & 1;
            int lo = R0 - 4; lo = lo < 0 ? 0 : (lo > 120 ? 120 : lo);
            int hi = R0 + 3 - 4; hi = hi < 0 ? 0 : (hi > 120 ? 120 : hi); hi += 7;
            int wlo = rq - 4; wlo = wlo < 0 ? 0 : (wlo > 120 ? 120 : wlo);
            MaskNARS M; M.lo = lo; M.rq = rq; M.ch = ch; M.wlo = wlo; M.NL = hi - lo + 1; M.rpb = rl + hh * 465;
            qrow = b * SEQ + rq * 64 + ch * 32;
            const int kc[1] = {2048 + 64 * hh};
            attn_core_rs<1, 64, MaskNARS>(F, P, EVN, qrow, 1536 + 64 * hh, kc, 2560 + 64 * hh, 0, M.NL, b * SEQ + lo * 64, T + b * CTXL, negoff, M, o, lsum);
        } else {
            const int v = u - 1024, b = v >> 3; hh = v & 7;
            MaskNARS M; M.lo = 0; M.rq = 0; M.ch = 0; M.wlo = 0; M.NL = 0; M.rpb = rl;
            qrow = T + b * CTXL + 32 * w;
            const int kc[1] = {2048 + 64 * hh};
            attn_core_rs<1, 64, MaskNARS>(F, P, EVN, qrow, 1536 + 64 * hh, kc, 2560 + 64 * hh, 0, 0, 0, T + b * CTXL, negoff, M, o, lsum);
        }
        epi64(F, o, lsum, 0.f, Y, qrow, 512 + 64 * hh);
    }
}

DI void attn_odd(const Frame& F0, bool do_ctx, const f16* P, f16* Y, const float* cqg, const float* ckg, const float* sink, const float* dqg, const float* dkg,
                 const float* lq1, const float* lk1, const float* lq2, const float* lk2, const float* subg, float lam_init) {
    Frame F = phase_frame(F0);
    using namespace att;
    const int w = F.wave, lane = F.lane;
    {
        const float negoff = 0.f;
        const float lam = expf(wave_sum(lq1[lane] * lk1[lane])) - expf(wave_sum(lq2[lane] * lk2[lane])) + lam_init;
        const int map = w & 1, qg_ = w >> 1;
        for (int u = F.vcu; u < (do_ctx ? 1024 + 32 : 1024); u += F.G) {
            int b, hh, q0row, NL;
            if (u < 1024) { const int bh = u >> 6, qb = u & 63; b = bh >> 2; hh = bh & 3; q0row = b * SEQ + 128 * qb; NL = 128; }
            else { const int v = u - 1024, bh = v >> 1, qb = v & 1; b = bh >> 2; hh = bh & 3; q0row = T + b * CTXL + 128 * qb; NL = 0; }
            f32x16 o[4]; f32x16 osum;
            const int kc[2] = {1280 + 128 * hh, 1280 + 128 * hh + 64};
            MaskNone M;
            attn_core<2, 128, MaskNone>(F, P, ODN, q0row + 32 * qg_, 512 + 128 * hh + 64 * map, (const unsigned char*)P + WS_V8OFF + WS_K8REL + (size_t)hh * (MR / 64) * 8192, (const unsigned char*)P + WS_V8OFF + (size_t)hh * (MR / 64) * 8192, map, NL, b * SEQ, T + b * CTXL, negoff, M, o, osum);
            const int r = lane & 31, h = lane >> 5;
            float rli[16];
#pragma unroll
            for (int i = 0; i < 16; ++i) rli[i] = fast_rcp(osum[i]);
            LAS float* E = (LAS float*)F.lds;
            if (map == 1) {
#pragma unroll
                for (int c = 0; c < 4; ++c)
#pragma unroll
                    for (int i = 0; i < 16; ++i) E[(32 * qg_ + crow(i, h)) * 132 + 32 * c + r] = lam * o[c][i] * rli[i];
            }
            __syncthreads();
            if (map == 0) {
#pragma unroll
                for (int c = 0; c < 4; ++c) { float ev[16];
#pragma unroll
                    for (int i = 0; i < 16; ++i) ev[i] = E[(32 * qg_ + crow(i, h)) * 132 + 32 * c + r];
                    asm volatile("" : "+v"(ev[0]), "+v"(ev[1]), "+v"(ev[2]), "+v"(ev[3]), "+v"(ev[4]), "+v"(ev[5]), "+v"(ev[6]), "+v"(ev[7]), "+v"(ev[8]), "+v"(ev[9]), "+v"(ev[10]), "+v"(ev[11]), "+v"(ev[12]), "+v"(ev[13]), "+v"(ev[14]), "+v"(ev[15]));
#pragma unroll
                    for (int i = 0; i < 16; ++i) E[(32 * qg_ + crow(i, h)) * 132 + 32 * c + r] = o[c][i] * rli[i] - ev[i]; }
            }
            __syncthreads();
            { const int qq = F.tid >> 2, part = F.tid & 3; const LAS float* er = E + qq * 132 + 32 * part;
              f32x4 sg[8];
#pragma unroll
              for (int k = 0; k < 8; ++k) sg[k] = *(const f32x4*)(subg + 32 * part + 4 * k);
              asm volatile("" : "+v"(sg[0]), "+v"(sg[1]), "+v"(sg[2]), "+v"(sg[3]), "+v"(sg[4]), "+v"(sg[5]), "+v"(sg[6]), "+v"(sg[7]));
              float v[32]; float ss = 0.f;
#pragma unroll
              for (int j = 0; j < 8; ++j) { const f32x4 x4 = *(const LAS f32x4*)(er + 4 * j); v[4 * j] = x4[0]; v[4 * j + 1] = x4[1]; v[4 * j + 2] = x4[2]; v[4 * j + 3] = x4[3]; ss += (x4[0] * x4[0] + x4[1] * x4[1]) + (x4[2] * x4[2] + x4[3] * x4[3]); }
              ss += __builtin_bit_cast(float, __builtin_amdgcn_update_dpp(0, __builtin_bit_cast(int, ss), 0xB1, 0xF, 0xF, false));
              ss += __builtin_bit_cast(float, __builtin_amdgcn_update_dpp(0, __builtin_bit_cast(int, ss), 0x4E, 0xF, 0xF, false));
              const float sc = __builtin_amdgcn_rsqf(ss * (1.0f / 128.0f) + EPS) * (1.0f - lam_init);
              f16* yp = Y + (size_t)(q0row + qq) * D + 512 + 128 * hh + 32 * part;
#pragma unroll
              for (int j = 0; j < 4; ++j) { float ov[8];
#pragma unroll
                  for (int e = 0; e < 8; ++e) ov[e] = v[8 * j + e] * sc * sg[2 * j + (e >> 2)][e & 3];
                  st8(yp + 8 * j, ov); } }
            __syncthreads();
        }
    }
    {
        const float negoff = 0.f;
        const int vshift = (F.vcu + F.G - (32 % F.G)) % F.G;
        for (int u0 = F.vcu; u0 < 1024 + F.G; u0 += F.G) {
            int u = u0; if (u0 >= 1024) { u = 1024 + vshift; if (vshift >= 32 || !do_ctx) break; }
            int b, kvh, qa, qrow, NL, tlo;
            if (u < 1024) { const int bk = u >> 7, jq = u & 127; b = bk >> 1; kvh = bk & 1; tlo = jq - 2 < 0 ? 0 : jq - 2; const int thi = jq + 2 > 127 ? 127 : jq + 2; NL = thi - tlo + 1;
                qa = 64 * jq + 32 * (w & 1); qrow = b * SEQ + qa; }
            else { const int v = u - 1024, bk = v >> 2, jq = v & 3; b = bk >> 1; kvh = bk & 1; tlo = 0; NL = 0; qa = 0; qrow = T + b * CTXL + 64 * jq + 32 * (w & 1); }
            const int head = kvh * 4 + (w >> 1);
            f32x16 o[2]; f32x16 osum;
            MaskSWA M; M.ka0 = 64 * tlo; M.qa = qa; M.NL = NL;
            const unsigned char* img8 = (const unsigned char*)P + WS_V8OFF + (size_t)kvh * (MR / 64) * 4096;
            attn_core_swa8<MaskSWA>(F, P, ODN, qrow, 64 * head, img8 + WS_CK8REL, img8 + WS_CV8REL, NL, b * SEQ + 64 * tlo, T + b * CTXL, M, o, osum);
            epi64s(F, o, osum, fast_exp2(sink[head] * LOG2E - 4.0f), Y, qrow, 64 * head);
        }
    }
}

__global__ void __launch_bounds__(NTHREADS, 2) fwd_kernel(Args a_unused) {
    extern __shared__ __attribute__((aligned(16))) unsigned char lds_raw[];
    __builtin_amdgcn_s_setreg((0 << 11) | (23 << 6) | 1, 1);
    Frame F;
    F.lds = (LAS unsigned char*)lds_raw;
    F.tid = threadIdx.x; F.lane = F.tid & 63; F.wave = __builtin_amdgcn_readfirstlane(F.tid >> 6);
    F.G = gridDim.x; { const int bx = blockIdx.x; F.vcu = (F.G % 8 == 0) ? (bx % 8) * (F.G / 8) + bx / 8 : bx; }
    typedef const __attribute__((address_space(4))) Args* KArgsP;
    KArgsP kap = (KArgsP)__builtin_amdgcn_kernarg_segment_ptr();
#define KA() ({ KArgsP _p = kap; asm volatile("" : "+s"(_p)); _p; })
    unsigned* ctl0 = (unsigned*)(KA()->ws + WS_CTL);
    for (int u = F.tid; u < (LDS_BYTES - LDSCTL_OFF) / 4; u += NTHREADS) ((LAS unsigned*)(F.lds + LDSCTL_OFF))[u] = 0u;
    __syncthreads();
    (void)xcd_barrier_post(ctl0 + CW_BAR, (volatile LAS unsigned*)(F.lds + LDSCTL_OFF + 64), F.wave);
#define GRID_BAR() do { XcdBarrier b_; b_.bar = (unsigned*)(ws + WS_CTL) + CW_BAR; b_.x = xb_xcc_id(); b_.st = (volatile LAS unsigned*)(F.lds + LDSCTL_OFF + 64); b_.w = F.wave; xcd_barrier(b_); } while (0)
#ifndef PM
#define PM 0xFFFFFFFFu
#endif
#ifndef DUPM
#define DUPM 0u
#endif
#define TAIL(nwg_, ...) do { const int rem_ = (nwg_) % F.G; if (bx >= rem_) { Frame Tf = F; Tf.vcu = bx - rem_; Tf.G = F.G - rem_; __VA_ARGS__; } } while (0)
#define PH(b) if constexpr ((PM >> (b)) & 1u) for (int rep_ = 0; rep_ < ((((DUPM) >> (b)) & 1u) ? 2 : 1); ++rep_, ({ if (rep_ == 1 && (((DUPM) >> (b)) & 1u)) GRID_BAR(); }))
#define ws (KA()->ws)
#define mod ((float*)(ws + WS_MOD))
#define Wlist ((int*)(ws + WS_LIST))
#define Wgate ((float*)(ws + WS_GATE))
#define H16 ((f16*)(ws + WS_H16))
#define BIG ((f16*)(ws + WS_BIG))
#define R0 ((f16*)(ws + WS_R0))
#define R1 ((f16*)(ws + WS_R1))
#define R2 ((f16*)(ws + WS_R2))
#define bx ((int)blockIdx.x)

    PH(0) p0_prologue(F, KA());
    GRID_BAR();

    for (int lp = 0; lp < 2; ++lp) {
        {
            const int l = 2 * lp;
            const float* modl = mod + (size_t)l * 5 * 6144;
            const unsigned char* wl = ws + WS_WEV + (size_t)lp * EVW_SZ;
            PH(1) { RowPassP p{}; p.H = H16; p.modn = modl; p.sc_chunk = 1; p.sh_chunk = 0; p.normg = KA()->norm1_g + l * D; p.Aout = R2; p.nrows = MR; p.rscale = (float*)(ws + WS_RS);
              if (lp == 0) { p.xin_lat = KA()->x; p.xin_ctx = KA()->ctx; row_pass<0, true, false, true, true, false, Q_G1E>(F, p); }
              else { p.ysrc = R0; p.gatew = Wgate; p.modg = mod + (size_t)(l - 1) * 5 * 6144; p.gate_chunk = 5; row_pass<2, true, false, true, false, false, Q_G1E>(F, p); } }
            GRID_BAR();
            PH(2) { LAS float* gl = (LAS float*)(F.lds + LDSCTL_OFF + 512); const int tid_ = phase_frame(F).tid;
              if (tid_ < 128) gl[tid_] = tid_ < 64 ? KA()->ev_q_g[lp * 64 + tid_] * QSCALE : KA()->ev_k_g[lp * 64 + tid_ - 64];
              __syncthreads();
              constexpr int KK = Q_G1E ? D / 2 : D; pg8::StaticOrder S; S.init(MR, EVN, KK, F.G, bx); pg8::EpiHeads<false> E{BIG, EVN, gl, nullptr};
              pg8::gemm_phase<pg8::EpiHeads<false>, pg8::StaticOrder, Q_G1E>(F.lds, F.wave, R2, (const f16*)(wl + EVW_IN), KK, S, E, (const float*)(ws + WS_RS), (const float*)(ws + WS_CS_EVIN) + (size_t)lp * EVN);
              if (lp == 0) TAIL((MR / 256) * (EVN / 256), conv_even_layer(Tf, KA()->ev_w_in, KA()->ev_w_out, KA()->ffn_w1, KA()->ffn_w3, KA()->ffn_w2, ws, 0, 2));
              else TAIL((MR / 256) * (EVN / 256), moe_convert(Tf, KA()->moe_w1, KA()->moe_w3, KA()->moe_w2, ws, lp, 2)); }
            GRID_BAR();
            PH(3) conv_even(F, BIG, R0, KA()->ev_conv_w + lp * 3 * 512);
            PH(4) attn_even(F, BIG, R0, KA()->ev_q_g + lp * 64, KA()->ev_k_g + lp * 64, KA()->ev_rpb + lp * 8 * 465);
            GRID_BAR();
            PH(5) { pg8::StaticOrder S; S.init(MR, D, D, F.G, bx); pg8::EpiResid E{H16, modl + 2 * 1024}; pg8::gemm_phase(F.lds, F.wave, R0, (const f16*)(wl + EVW_OUT), D, S, E);
              TAIL((MR / 256) * (D / 256), if (lp == 0) conv_odd_layer(Tf, KA()->od_w_in, KA()->od_w_out, ws, 0); moe_convert(Tf, KA()->moe_w1, KA()->moe_w3, KA()->moe_w2, ws, lp, 1)); }
            GRID_BAR();
            PH(6) { RowPassP p{}; p.H = H16; p.modn = modl; p.sc_chunk = 4; p.sh_chunk = 3; p.normg = KA()->norm2_g + l * D; p.Aout = R2; p.nrows = MR; p.rscale = (float*)(ws + WS_RS); row_pass<0, true, false, false, false, false, Q_G3E>(F, p); }
            GRID_BAR();
            PH(7) { constexpr int KK = Q_G3E ? D / 2 : D; pg8::StaticOrder S; S.init(MR, 2 * DFF, KK, F.G, bx); pg8::EpiSwiglu<F8_G4> E{BIG, DFF, 0};
              pg8::gemm_phase<pg8::EpiSwiglu<F8_G4>, pg8::StaticOrder, Q_G3E>(F.lds, F.wave, R2, (const f16*)(wl + EVW_13), KK, S, E, (const float*)(ws + WS_RS), (const float*)(ws + WS_CS_F13) + (size_t)lp * 2 * DFF);
              if (lp == 1) TAIL((MR / 256) * (2 * DFF / 256), moe_convert(Tf, KA()->moe_w1, KA()->moe_w3, KA()->moe_w2, ws, lp, 4)); }
            GRID_BAR();
            PH(8) { constexpr int KK = F8_G4 ? DFF / 2 : DFF; constexpr int QM4 = F8_G4 ? 1 : 0;
              pg8::StaticOrder S; S.init(T, D, KK, F.G, bx); pg8::EpiResid E{H16, modl + 5 * 1024}; pg8::gemm_phase<pg8::EpiResid, pg8::StaticOrder, QM4>(F.lds, F.wave, BIG, (const f16*)(wl + EVW_2), KK, S, E);
              { const int unit = bx >> 1, half = bx & 1; pg8::OneUnit P1; P1.pm = T / 256 + ((unit >> 2) & 3); P1.pn = unit & 3; P1.K = KK; P1.on = bx < 32;
                pg8::EpiPairResid EP{H16, modl + 5 * 1024, (float*)(ws + WS_PART) + (size_t)(unit & 15) * 65536, (unsigned*)(ws + WS_CTL) + CW_PAIR + ((lp * 3 + 1) * 16 + (unit & 15)) * 16, half};
                constexpr int NT0 = ((KK / pg8::BK / 2) / 2) * 2, NT1 = KK / pg8::BK - NT0;
                const size_t koff = (size_t)half * NT0 * pg8::BK * 2;
                pg8::gemm_phase<pg8::EpiPairResid, pg8::OneUnit, QM4>(F.lds, F.wave, (const f16*)((const char*)BIG + koff), (const f16*)(wl + EVW_2 + koff), KK, P1, EP, nullptr, nullptr, half ? NT1 : NT0); }
              TAIL(32, moe_convert(Tf, KA()->moe_w1, KA()->moe_w3, KA()->moe_w2, ws, lp, lp == 0 ? 6 : 0)); }
            GRID_BAR();
        }
        {
            const int l = 2 * lp + 1;
            const float* modl = mod + (size_t)l * 5 * 6144;
            const unsigned char* wl = ws + WS_WOD + (size_t)lp * ODS_SZ;
            unsigned* cnt = (unsigned*)(ws + WS_CTL) + CW_CNT + lp * 8 * 64;
            PH(9) { RowPassP p{}; p.H = H16; p.modn = modl; p.sc_chunk = 1; p.sh_chunk = 0; p.normg = KA()->norm1_g + l * D; p.Aout = R1; p.nrows = MR; p.rscale = (float*)(ws + WS_RS); row_pass<0, true, false, false, false, false, Q_G1O>(F, p); }
            GRID_BAR();
            PH(10) { LAS float* gl = (LAS float*)(F.lds + LDSCTL_OFF + 512); const int tid_ = phase_frame(F).tid;
              if (tid_ < 256) { const int gsel_ = tid_ >> 6, d_ = tid_ & 63; const float* gp_ = gsel_ == 0 ? KA()->od_cq_g : gsel_ == 1 ? KA()->od_dq_g : gsel_ == 2 ? KA()->od_ck_g : KA()->od_dk_g; gl[tid_] = gp_[lp * 64 + d_] * (gsel_ < 2 ? QSCALE : 1.0f); }
              __syncthreads();
              constexpr int KK = Q_G1O ? D / 2 : D; pg8::StaticOrder S; S.init(MR, ODN, KK, F.G, bx); pg8::EpiHeads<true> E{BIG, ODN, gl, (unsigned char*)BIG + WS_V8OFF};
              pg8::gemm_phase<pg8::EpiHeads<true>, pg8::StaticOrder, Q_G1O>(F.lds, F.wave, R1, (const f16*)(wl + ODW_IN), KK, S, E, (const float*)(ws + WS_RS), (const float*)(ws + WS_CS_ODIN) + (size_t)lp * ODN);
              if (lp == 0) TAIL((MR / 256) * (ODN / 256), conv_odd_layer(Tf, KA()->od_w_in, KA()->od_w_out, ws, 1)); }
            GRID_BAR();
            const int Mq = (lp == 1) ? T : MR;
            PH(12) attn_odd(F, lp == 0, BIG, R2, KA()->od_cq_g + lp * 64, KA()->od_ck_g + lp * 64, KA()->od_sink + lp * 8, KA()->od_dq_g + lp * 64, KA()->od_dk_g + lp * 64,
                     KA()->od_lam_q1 + lp * 64, KA()->od_lam_k1 + lp * 64, KA()->od_lam_q2 + lp * 64, KA()->od_lam_k2 + lp * 64, KA()->od_subln_g + lp * 128, 0.8f - 0.6f * expf(-0.3f * (float)l));
            GRID_BAR();
            PH(13) { pg8::StaticOrder S; S.init(Mq, D, D, F.G, bx); pg8::EpiResid E{H16, modl + 2 * 1024}; pg8::gemm_phase(F.lds, F.wave, R2, (const f16*)(wl + ODW_OUT), D, S, E);
              if (lp == 0) TAIL((Mq / 256) * (D / 256), conv_even_layer(Tf, KA()->ev_w_in, KA()->ev_w_out, KA()->ffn_w1, KA()->ffn_w3, KA()->ffn_w2, ws, 1)); }
            GRID_BAR();
            PH(14) { RowPassP p{}; p.H = H16; p.modn = modl; p.sc_chunk = 4; p.sh_chunk = 3; p.normg = KA()->norm2_g + l * D; p.Aout = R1;
              p.router = KA()->moe_router + (size_t)lp * D * NE; p.list = Wlist; p.cnt = cnt; p.gateout = Wgate; p.nrows = Mq; p.rscale = (float*)(ws + WS_RS); row_pass<0, true, true, false, false, false, Q_G3G>(F, p); }
            GRID_BAR();
            PH(15) { pg8::GroupOrder<true> S; constexpr int KK = Q_G3G ? D / 2 : D; S.init(cnt, (LAS int*)(F.lds + LDSCTL_OFF + 256), 2 * DFE, KK, F.G, bx, Wlist, F.wave); pg8::EpiSwiglu<F8_G4G, F8_G4G> E{BIG, F8_G4G ? DFEP : DFE, 2 * DFE / 256};
              pg8::gemm_phase<pg8::EpiSwiglu<F8_G4G, F8_G4G>, pg8::GroupOrder<true>, Q_G3G>(F.lds, F.wave, R1, (const f16*)(ws + WS_MOE + MOE_13), KK, S, E, (const float*)(ws + WS_RS), (const float*)(ws + WS_CS_MOE)); }
            GRID_BAR();
            PH(16) { constexpr int KK = F8_G4G ? DFEP / 2 : DFE; pg8::GroupOrder<false> S; S.init(cnt, (LAS int*)(F.lds + LDSCTL_OFF + 256), D, KK, F.G, bx, Wlist, F.wave); pg8::EpiScatter E{R0, Wlist};
              pg8::gemm_phase<pg8::EpiScatter, pg8::GroupOrder<false>, F8_G4G ? 1 : 0>(F.lds, F.wave, BIG, (const f16*)(ws + WS_MOE + MOE_2), KK, S, E); }
            GRID_BAR();
        }
    }
    PH(17) { RowPassP p{}; p.H = H16; p.out32 = KA()->out; p.ysrc = R0; p.gatew = Wgate; p.modg = mod + (size_t)3 * 5 * 6144; p.gate_chunk = 5; p.nrows = T;
      row_pass<2, false, false, false, false, true>(F, p); }
}

#undef ws
#undef mod
#undef Wlist
#undef Wgate
#undef H16
#undef BIG
#undef R0
#undef R1
#undef R2
#undef bx
extern "C" void kernel_launch(void* const* d_in, const int* in_sizes, int n_in, void* d_out, int out_size, void* d_ws, size_t ws_size, hipStream_t stream) {
    static int grid = 0;
    if (grid == 0) {
        if (n_in != 33 || out_size != T * D || ws_size < WS_END) { fprintf(stderr, "kernel_launch: unexpected shapes (n_in %d, out %d, ws %zu, need %zu)\n", n_in, out_size, ws_size, (size_t)WS_END); grid = -1; return; }
        int dev = 0, cus = 0, per_cu = 0;
        if (hipGetDevice(&dev) != hipSuccess || hipDeviceGetAttribute(&cus, hipDeviceAttributeMultiprocessorCount, dev) != hipSuccess) { grid = -1; return; }
        if (hipFuncSetAttribute((const void*)fwd_kernel, hipFuncAttributeMaxDynamicSharedMemorySize, LDS_BYTES) != hipSuccess) { grid = -1; return; }
        if (hipOccupancyMaxActiveBlocksPerMultiprocessor(&per_cu, (const void*)fwd_kernel, NTHREADS, LDS_BYTES) != hipSuccess || per_cu < 1) { fprintf(stderr, "kernel_launch: occupancy query reports %d\n", per_cu); }
        (void)hipGetLastError();
        grid = cus;
    }
    if (grid < 0) return;
    if (hipMemsetAsync((char*)d_ws + WS_CTL, 0, CTL_ZERO_BYTES, stream) != hipSuccess) return;
    Args a{};
    const float* const* in = (const float* const*)d_in;
    a.x = in[0]; a.c = in[1]; a.ctx = in[2]; a.c_ctx = in[3]; a.ada_w = in[4]; a.ada_b = in[5]; a.norm1_g = in[6]; a.norm2_g = in[7];
    a.ev_w_in = in[8]; a.ev_conv_w = in[9]; a.ev_q_g = in[10]; a.ev_k_g = in[11]; a.ev_rpb = in[12]; a.ev_w_out = in[13];
    a.ffn_w1 = in[14]; a.ffn_w3 = in[15]; a.ffn_w2 = in[16];
    a.od_w_in = in[17]; a.od_cq_g = in[18]; a.od_ck_g = in[19]; a.od_sink = in[20]; a.od_dq_g = in[21]; a.od_dk_g = in[22];
    a.od_lam_q1 = in[23]; a.od_lam_k1 = in[24]; a.od_lam_q2 = in[25]; a.od_lam_k2 = in[26]; a.od_subln_g = in[27]; a.od_w_out = in[28];
    a.moe_router = in[29]; a.moe_w1 = in[30]; a.moe_w3 = in[31]; a.moe_w2 = in[32];
    a.out = (float*)d_out; a.ws = (unsigned char*)d_ws;
    hipLaunchKernelGGL(fwd_kernel, dim3(grid), dim3(NTHREADS), LDS_BYTES, stream, a);
}
```
